# Optimizing an MI355X kernel written in HIP

```python
import jax, jax.numpy as jnp
from jax import lax
import numpy as np

D_MODEL = 1024
BATCH = 16
SEQ = 2048
DEPTH = 1
DEC_BATCH = 1
DEC_SEQ = 16384
PAST_LEN = 128

GRID_W = 64
ATTN_HEADS = 8
ATTN_KV_HEADS = 2
ATTN_HEAD_DIM = 64
RET_HEADS = 4
RET_KEY_DIM = 128
RET_VALUE_DIM = 256
ATTN_Q_W = ATTN_HEADS * ATTN_HEAD_DIM
ATTN_KV_W = ATTN_KV_HEADS * ATTN_HEAD_DIM
RET_QK_W = RET_HEADS * RET_KEY_DIM
RET_V_W = RET_HEADS * RET_VALUE_DIM
IN_PROJ_W = ATTN_Q_W + 2 * ATTN_KV_W + 2 * RET_QK_W + 2 * RET_V_W + 2 * D_MODEL
D_FF = -(-8 * D_MODEL // (3 * 256)) * 256
Q_BLOCK = 128
RET_CHUNK = 128
ROPE_THETA = 10000.0
EPS = 1e-6

kernel_name = "hybrid_gqa_axial_retention_encoder"


def rms_norm(x, gain):
    xf = x.astype(jnp.float32)
    y = xf * lax.rsqrt(jnp.mean(xf * xf, axis=-1, keepdims=True) + EPS)
    return (y * gain.astype(jnp.float32)).astype(x.dtype)


def axial_rope_tables(n_tokens, head_dim):
    n_rows = n_tokens // GRID_W
    row = jnp.repeat(jnp.arange(n_rows, dtype=jnp.float32), GRID_W)
    col = jnp.tile(jnp.arange(GRID_W, dtype=jnp.float32), n_rows)
    n_freq = head_dim // 4
    inv_freq = ROPE_THETA ** (-jnp.arange(n_freq, dtype=jnp.float32) / n_freq)
    ang = jnp.concatenate([row[:, None] * inv_freq, col[:, None] * inv_freq], axis=-1)
    return jnp.cos(ang), jnp.sin(ang)


def apply_rope(x, cos, sin):
    xf = x.astype(jnp.float32).reshape(x.shape[:-1] + (x.shape[-1] // 2, 2))
    c = cos[None, :, None, :]
    s = sin[None, :, None, :]
    x0, x1 = xf[..., 0], xf[..., 1]
    out = jnp.stack([x0 * c - x1 * s, x0 * s + x1 * c], axis=-1)
    return out.reshape(x.shape).astype(x.dtype)


def axial_gqa_attention(q, k, v, q_gain, k_gain):
    B, T = q.shape[0], q.shape[1]
    cos, sin = axial_rope_tables(T, ATTN_HEAD_DIM)
    q = apply_rope(rms_norm(q, q_gain), cos, sin)
    k = apply_rope(rms_norm(k, k_gain), cos, sin)
    group = ATTN_HEADS // ATTN_KV_HEADS
    scale = ATTN_HEAD_DIM ** -0.5
    n_blocks = T // Q_BLOCK
    q_blocks = q.reshape(B, n_blocks, Q_BLOCK, ATTN_KV_HEADS, group, ATTN_HEAD_DIM).transpose(1, 0, 2, 3, 4, 5)

    def one_block(qb):
        s = jnp.einsum('bqkgd,bskd->bkgqs', qb, k, preferred_element_type=jnp.float32) * scale
        p = jax.nn.softmax(s, axis=-1).astype(v.dtype)
        return jnp.einsum('bkgqs,bskd->bqkgd', p, v)

    out = lax.map(one_block, q_blocks)
    return out.transpose(1, 0, 2, 3, 4, 5).reshape(B, T, ATTN_Q_W)


def retention_one_direction(q, k, v, log_gamma, strict):
    B, T, H, dk = q.shape
    dv = v.shape[-1]
    C = RET_CHUNK
    N = T // C
    qc = q.reshape(B, N, C, H, dk)
    kc = k.reshape(B, N, C, H, dk)
    vc = v.reshape(B, N, C, H, dv)
    pos = jnp.arange(C, dtype=jnp.float32)
    diff = pos[:, None] - pos[None, :]
    mask = (diff > 0) if strict else (diff >= 0)
    decay_intra = jnp.where(mask[None], jnp.exp(log_gamma[:, None, None] * jnp.maximum(diff, 0.0)[None]), 0.0)
    scores = jnp.einsum('bnihd,bnjhd->bnhij', qc, kc) * decay_intra
    intra = jnp.einsum('bnhij,bnjhe->bnihe', scores, vc)
    k_decay = jnp.exp(log_gamma[None, :] * (C - 1 - pos)[:, None])
    chunk_kv = jnp.einsum('bnjhd,bnjhe->nbhde', kc * k_decay[:, :, None], vc)
    chunk_decay = jnp.exp(log_gamma * C)[:, None, None]

    def step(state, kv):
        return chunk_decay * state + kv, state

    _, prev_states = lax.scan(step, jnp.zeros((B, H, dk, dv), jnp.float32), chunk_kv)
    q_decay = jnp.exp(log_gamma[None, :] * (pos + 1.0)[:, None])
    cross = jnp.einsum('bnihd,nbhde->bnihe', qc * q_decay[:, :, None], prev_states)
    return (intra + cross).reshape(B, T, H, dv)


def bidirectional_retention(q, k, v, gate, decay_fwd, decay_bwd, norm_gain):
    B, T = q.shape[0], q.shape[1]
    cos, sin = axial_rope_tables(T, RET_KEY_DIM)
    qf = apply_rope(q, cos, sin).astype(jnp.float32) * (RET_KEY_DIM ** -0.5)
    kf = apply_rope(k, cos, sin).astype(jnp.float32)
    vf = v.astype(jnp.float32)
    fwd = retention_one_direction(qf, kf, vf, jax.nn.log_sigmoid(decay_fwd.astype(jnp.float32)), False)
    bwd = retention_one_direction(qf[:, ::-1], kf[:, ::-1], vf[:, ::-1],
                                  jax.nn.log_sigmoid(decay_bwd.astype(jnp.float32)), True)[:, ::-1]
    y = fwd + bwd
    mean = jnp.mean(y, axis=-1, keepdims=True)
    var = jnp.mean(jnp.square(y - mean), axis=-1, keepdims=True)
    y = ((y - mean) * lax.rsqrt(var + EPS)).reshape(B, T, RET_V_W) * norm_gain.astype(jnp.float32)
    return (jax.nn.silu(gate.astype(jnp.float32)) * y).astype(gate.dtype)


def encoder_layer(x, norm_mix, w_in, b_gate, q_norm, k_norm, ret_decay_fwd, ret_decay_bwd,
                  ret_norm, w_branch_attn, w_branch_ret, w_out, norm_ffn, w_ffn_in, w_ffn_out):
    B, T, _ = x.shape
    h = rms_norm(x, norm_mix)
    proj = h @ w_in
    widths = [ATTN_Q_W, ATTN_KV_W, ATTN_KV_W, RET_QK_W, RET_QK_W, RET_V_W, RET_V_W]
    q_a, k_a, v_a, q_r, k_r, v_r, g_r, gate_logits = jnp.split(proj, list(np.cumsum(widths)), axis=-1)
    attn = axial_gqa_attention(q_a.reshape(B, T, ATTN_HEADS, ATTN_HEAD_DIM),
                               k_a.reshape(B, T, ATTN_KV_HEADS, ATTN_HEAD_DIM),
                               v_a.reshape(B, T, ATTN_KV_HEADS, ATTN_HEAD_DIM), q_norm, k_norm)
    ret = bidirectional_retention(q_r.reshape(B, T, RET_HEADS, RET_KEY_DIM),
                                  k_r.reshape(B, T, RET_HEADS, RET_KEY_DIM),
                                  v_r.reshape(B, T, RET_HEADS, RET_VALUE_DIM),
                                  g_r, ret_decay_fwd, ret_decay_bwd, ret_norm)
    gates = jax.nn.sigmoid((gate_logits + b_gate).astype(jnp.float32)).astype(x.dtype)
    g_attn, g_ret = jnp.split(gates, 2, axis=-1)
    mixed = g_attn * (attn @ w_branch_attn) + g_ret * (ret @ w_branch_ret)
    x = x + mixed @ w_out
    h = rms_norm(x, norm_ffn)
    gt, up = jnp.split(h @ w_ffn_in, 2, axis=-1)
    return x + (jax.nn.silu(gt) * up) @ w_ffn_out


def run_trunk(x, norm_mix, w_in, b_gate, q_norm, k_norm, ret_decay_fwd, ret_decay_bwd, ret_norm,
              w_branch_attn, w_branch_ret, w_out, norm_ffn, w_ffn_in, w_ffn_out, norm_final):
    for l in range(DEPTH):
        x = encoder_layer(x, norm_mix[l], w_in[l], b_gate[l], q_norm[l], k_norm[l],
                          ret_decay_fwd[l], ret_decay_bwd[l], ret_norm[l], w_branch_attn[l],
                          w_branch_ret[l], w_out[l], norm_ffn[l], w_ffn_in[l], w_ffn_out[l])
    return rms_norm(x, norm_final)


def setup_inputs(seed: int = 0) -> dict:
    key = jax.random.key(seed)
    ks = jax.random.split(key, 20)
    f32 = jnp.float32

    def w(k, shape, fan_in):
        return jax.random.normal(k, shape, f32) * (fan_in ** -0.5)

    def gain(k, shape):
        return 1.0 + 0.02 * jax.random.normal(k, shape, f32)

    base_logit = jnp.log(jnp.exp2(5.0 + jnp.arange(RET_HEADS, dtype=f32)) - 1.0)
    return {
        "x_prompt": jax.random.normal(ks[0], (BATCH, SEQ, D_MODEL), f32),
        "x_sample": jax.random.normal(ks[1], (DEC_BATCH, DEC_SEQ, D_MODEL), f32),
        "norm_mix": gain(ks[2], (DEPTH, D_MODEL)),
        "w_in": w(ks[3], (DEPTH, D_MODEL, IN_PROJ_W), D_MODEL),
        "b_gate": 0.01 * jax.random.normal(ks[4], (DEPTH, 2 * D_MODEL), f32),
        "q_norm": gain(ks[5], (DEPTH, ATTN_HEAD_DIM)),
        "k_norm": gain(ks[6], (DEPTH, ATTN_HEAD_DIM)),
        "ret_decay_fwd": base_logit + 0.01 * jax.random.normal(ks[7], (DEPTH, RET_HEADS), f32),
        "ret_decay_bwd": base_logit + 0.01 * jax.random.normal(ks[8], (DEPTH, RET_HEADS), f32),
        "ret_norm": gain(ks[9], (DEPTH, RET_V_W)),
        "w_branch_attn": w(ks[10], (DEPTH, ATTN_Q_W, D_MODEL), ATTN_Q_W),
        "w_branch_ret": w(ks[11], (DEPTH, RET_V_W, D_MODEL), RET_V_W),
        "w_out": w(ks[12], (DEPTH, D_MODEL, D_MODEL), D_MODEL),
        "norm_ffn": gain(ks[13], (DEPTH, D_MODEL)),
        "w_ffn_in": w(ks[14], (DEPTH, D_MODEL, 2 * D_FF), D_MODEL),
        "w_ffn_out": w(ks[15], (DEPTH, D_FF, D_MODEL), D_FF),
        "norm_final": gain(ks[16], (D_MODEL,)),
    }


def reference(x_prompt, x_sample, norm_mix, w_in, b_gate, q_norm, k_norm, ret_decay_fwd, ret_decay_bwd,
              ret_norm, w_branch_attn, w_branch_ret, w_out, norm_ffn, w_ffn_in, w_ffn_out, norm_final):
    y_prompt = run_trunk(x_prompt, norm_mix, w_in, b_gate, q_norm, k_norm, ret_decay_fwd, ret_decay_bwd,
                         ret_norm, w_branch_attn, w_branch_ret, w_out, norm_ffn, w_ffn_in, w_ffn_out, norm_final)
    y_sample = run_trunk(x_sample, norm_mix, w_in, b_gate, q_norm, k_norm, ret_decay_fwd, ret_decay_bwd,
                         ret_norm, w_branch_attn, w_branch_ret, w_out, norm_ffn, w_ffn_in, w_ffn_out, norm_final)
    return (y_prompt, y_sample)
```

```cpp
#include <hip/hip_runtime.h>
#include <hip/hip_cooperative_groups.h>
#include <hip/hip_bf16.h>
#include <cstdio>
#include <cstdint>
#include <cmath>
namespace cg = cooperative_groups;
__device__ __forceinline__ int ltid() { int t = (int)threadIdx.x; asm volatile("" : "+v"(t)); return t; }
__device__ __forceinline__ int lsgpr(int v) { asm volatile("" : "+s"(v)); return v; }
namespace pg8 {
#define PG8_LAS __attribute__((address_space(3)))
typedef unsigned short bf16_t;
typedef short bf16x8 __attribute__((ext_vector_type(8)));
typedef float f32x4 __attribute__((ext_vector_type(4)));
typedef unsigned u32x4 __attribute__((ext_vector_type(4)));
constexpr int BM = 256, BK = 64, HALF = 128, HTB = HALF * BK * 2  , STAGE_BYTES = 8 * HTB, NXCD = 8, WGM = 8;

__host__ __device__ __forceinline__ int lds_byte(int r, int c) { const int st = (r >> 4) * 2 + (c >> 5), rr = r & 15, cc = c & 31, ob = rr * 64 + cc * 2; return st * 1024 + (ob ^ (((ob >> 9) & 1) << 5)); }
__host__ __device__ __forceinline__ void stage_rc(int b, int& R, int& C) { const int st = b / 1024, sb = b % 1024, swz = sb ^ (((sb >> 9) & 1) << 5); R = (st >> 1) * 16 + swz / 64; C = (st & 1) * 32 + (swz % 64) / 2; }
__host__ __device__ __forceinline__ int perm32(int rho) { const int n = rho >> 4, i = rho & 15; return 8 * (i >> 2) + 4 * n + (i & 3); }

struct Unit { int pm, pn; };
struct Gemm { const bf16_t* A; const bf16_t* Bt; int M, N, K; };

struct StaticOrder {
    int nM, nN, nwg, G, c;
    __host__ __device__ void init(int M, int N, int G_, int c_) { nM = M / BM; nN = N / BM; nwg = nM * nN; G = G_; c = c_; }
    __host__ __device__ bool next(int i, Unit& u) const {
        const long L = (long)i * G + c; if (L >= nwg) return false;
        int wgid = (int)L; { const int q = nwg / NXCD, r = nwg % NXCD, xcd = wgid % NXCD, off = wgid / NXCD; wgid = (xcd < r ? xcd * (q + 1) : r * (q + 1) + (xcd - r) * q) + off; }
        const int nig = WGM * nN, gid = wgid / nig, fm = gid * WGM, gsz = (nM - fm) < WGM ? (nM - fm) : WGM;
        u.pm = fm + ((wgid % nig) % gsz); u.pn = (wgid % nig) / gsz; return true;
    }
    __device__ __forceinline__ void a_ready(const Unit&) const {}
    __device__ __forceinline__ void done(const Unit&) const {}
};

__device__ __forceinline__ unsigned cvt_pk_bf16(float lo, float hi) { unsigned r; asm volatile("v_cvt_pk_bf16_f32 %0, %1, %2" : "=v"(r) : "v"(lo), "v"(hi)); return r; }
typedef float f32x2 __attribute__((ext_vector_type(2)));
__device__ __forceinline__ float sigm(float z) { return __builtin_amdgcn_rcpf(1.0f + __expf(-z)); }
__device__ __forceinline__ float bflo(unsigned u) { return __uint_as_float(u << 16); }
__device__ __forceinline__ float bfhi(unsigned u) { return __uint_as_float(u & 0xffff0000u); }
#define EPI_FENCE() do { asm volatile("" ::: "memory"); __builtin_amdgcn_sched_barrier(0); } while (0)
struct EpiProj {
    static constexpr bool PERM = true, AFTER_DRAIN = false;
    bf16_t* O; const float* bgate;
    __device__ __forceinline__ void operator()(const f32x4 (&acc)[2][2][4][2], const Unit& u, int wr, int wc, int fr, int fq) const {
        const int row0 = u.pm * BM + wr * 64 + fr; const int col0 = u.pn * BM + wc * 32 + 8 * fq;
        const int mode = u.pn >= 15 ? 2 : (u.pn >= 11 ? 1 : 0);
        f32x4 bv[2][2];
#pragma unroll
        for (int bj = 0; bj < 2; ++bj)
#pragma unroll
            for (int n = 0; n < 2; ++n) bv[bj][n] = (mode == 2) ? *(const f32x4*)(bgate + (col0 - 3840) + bj * HALF + 4 * n) : (f32x4){0.f, 0.f, 0.f, 0.f};
        const unsigned off0 = ((unsigned)row0 * 5888u + (unsigned)col0) * 2u;
#pragma unroll
        for (int ai = 0; ai < 2; ++ai)
#pragma unroll
            for (int m = 0; m < 4; ++m) { char* rowp = (char*)O + (off0 + (unsigned)(ai * HALF + m * 16) * 11776u);
#pragma unroll
                for (int bj = 0; bj < 2; ++bj) { f32x4 v0 = acc[ai][bj][m][0] + bv[bj][0], v1 = acc[ai][bj][m][1] + bv[bj][1];
                    if (mode == 1) {
#pragma unroll
                        for (int e = 0; e < 4; ++e) { v0[e] = v0[e] * sigm(v0[e]); v1[e] = v1[e] * sigm(v1[e]); } }
                    else if (mode == 2) {
#pragma unroll
                        for (int e = 0; e < 4; ++e) { v0[e] = sigm(v0[e]); v1[e] = sigm(v1[e]); } }
                    u32x4 w; w.x = cvt_pk_bf16(v0[0], v0[1]); w.y = cvt_pk_bf16(v0[2], v0[3]); w.z = cvt_pk_bf16(v1[0], v1[1]); w.w = cvt_pk_bf16(v1[2], v1[3]);
                    *(u32x4*)(rowp + bj * HALF * 2) = w; }
                EPI_FENCE(); }
    }
};
template <bool ADD> struct EpiBranch {
    static constexpr bool PERM = true, AFTER_DRAIN = false;
    const bf16_t* G; bf16_t* O;
    __device__ __forceinline__ void operator()(const f32x4 (&acc)[2][2][4][2], const Unit& u, int wr, int wc, int fr, int fq) const {
        const int row0 = u.pm * BM + wr * 64 + fr; const int col0 = u.pn * BM + wc * 32 + 8 * fq;
        const unsigned goff0 = ((unsigned)row0 * 5888u + (unsigned)col0) * 2u, ooff0 = ((unsigned)row0 * 1024u + (unsigned)col0) * 2u;
#pragma unroll
        for (int ai = 0; ai < 2; ++ai)
#pragma unroll
            for (int m = 0; m < 4; ++m) { const unsigned rr = (unsigned)(ai * HALF + m * 16);
#pragma unroll
                for (int bj = 0; bj < 2; ++bj) {
                    const u32x4 g = *(const u32x4*)((const char*)G + (goff0 + rr * 11776u + bj * 256u));
                    f32x4 v0 = acc[ai][bj][m][0], v1 = acc[ai][bj][m][1];
                    v0[0] *= bflo(g.x); v0[1] *= bfhi(g.x); v0[2] *= bflo(g.y); v0[3] *= bfhi(g.y);
                    v1[0] *= bflo(g.z); v1[1] *= bfhi(g.z); v1[2] *= bflo(g.w); v1[3] *= bfhi(g.w);
                    char* op = (char*)O + (ooff0 + rr * 2048u + bj * 256u);
                    if (ADD) { const u32x4 p = *(const u32x4*)op;
                        v0[0] += bflo(p.x); v0[1] += bfhi(p.x); v0[2] += bflo(p.y); v0[3] += bfhi(p.y);
                        v1[0] += bflo(p.z); v1[1] += bfhi(p.z); v1[2] += bflo(p.w); v1[3] += bfhi(p.w); }
                    u32x4 w; w.x = cvt_pk_bf16(v0[0], v0[1]); w.y = cvt_pk_bf16(v0[2], v0[3]); w.z = cvt_pk_bf16(v1[0], v1[1]); w.w = cvt_pk_bf16(v1[2], v1[3]);
                    *(u32x4*)op = w; EPI_FENCE(); } }
    }
};
struct EpiResid {
    static constexpr bool PERM = true, AFTER_DRAIN = false;
    const float* base; float* out; bf16_t* ob; float* ss;
    __device__ __forceinline__ void operator()(const f32x4 (&acc)[2][2][4][2], const Unit& u, int wr, int wc, int fr, int fq) const {
        const int row0 = u.pm * BM + wr * 64 + fr; const int col0 = u.pn * BM + wc * 32 + 8 * fq;
        const unsigned off0 = ((unsigned)row0 * 1024u + (unsigned)col0) * 4u;
#pragma unroll
        for (int ai = 0; ai < 2; ++ai)
#pragma unroll
            for (int m = 0; m < 4; ++m) { const unsigned rr = (unsigned)(ai * HALF + m * 16); float s = 0.f;
#pragma unroll
                for (int bj = 0; bj < 2; ++bj) { const unsigned off = off0 + rr * 4096u + bj * 512u;
                    const f32x4 b0 = *(const f32x4*)((const char*)base + off), b1 = *(const f32x4*)((const char*)base + off + 16);
                    const f32x4 v0 = acc[ai][bj][m][0] + b0, v1 = acc[ai][bj][m][1] + b1;
                    *(f32x4*)((char*)out + off) = v0; *(f32x4*)((char*)out + off + 16) = v1;
                    s += (v0[0] * v0[0] + v0[1] * v0[1]) + (v0[2] * v0[2] + v0[3] * v0[3]) + (v1[0] * v1[0] + v1[1] * v1[1]) + (v1[2] * v1[2] + v1[3] * v1[3]);
                    if (ob) { u32x4 w; w.x = cvt_pk_bf16(v0[0], v0[1]); w.y = cvt_pk_bf16(v0[2], v0[3]); w.z = cvt_pk_bf16(v1[0], v1[1]); w.w = cvt_pk_bf16(v1[2], v1[3]); *(u32x4*)((char*)ob + (off >> 1)) = w; }
                    EPI_FENCE(); }
                s += __shfl_xor(s, 16); s += __shfl_xor(s, 32);
                if (fq == 0) ss[(unsigned)(row0 + rr) * 16u + u.pn * 4 + wc] = s; }
    }
};
struct EpiFfnIn {
    static constexpr bool PERM = true, AFTER_DRAIN = false;
    const float* ss; bf16_t* O;
    __device__ __forceinline__ void operator()(const f32x4 (&acc)[2][2][4][2], const Unit& u, int wr, int wc, int fr, int fq) const {
        const int row0 = u.pm * BM + wr * 64 + fr; const int col0 = u.pn * HALF + wc * 32 + 8 * fq;
        const unsigned off0 = ((unsigned)row0 * 2816u + (unsigned)col0) * 2u, soff0 = ((unsigned)row0 * 16u + 4u * fq) * 4u;
#pragma unroll
        for (int ai = 0; ai < 2; ++ai)
#pragma unroll
            for (int m = 0; m < 4; ++m) { const unsigned rr = (unsigned)(ai * HALF + m * 16);
                const f32x4 s0 = *(const f32x4*)((const char*)ss + (soff0 + rr * 64u));
                float tot = (s0[0] + s0[1]) + (s0[2] + s0[3]); tot += __shfl_xor(tot, 16); tot += __shfl_xor(tot, 32);
                const float r = rsqrtf(tot * (1.0f / 1024.0f) + 1e-6f);
                float o[8];
#pragma unroll
                for (int n = 0; n < 2; ++n)
#pragma unroll
                    for (int e = 0; e < 4; ++e) { const float gt = acc[ai][0][m][n][e] * r, up = acc[ai][1][m][n][e] * r; o[4 * n + e] = gt * sigm(gt) * up; }
                u32x4 w; w.x = cvt_pk_bf16(o[0], o[1]); w.y = cvt_pk_bf16(o[2], o[3]); w.z = cvt_pk_bf16(o[4], o[5]); w.w = cvt_pk_bf16(o[6], o[7]);
                *(u32x4*)((char*)O + (off0 + rr * 5632u)) = w; EPI_FENCE(); }
    }
};
template <class Epi, class Sched, bool ALIGN_EPI = false, bool SP2 = false>
__device__ __forceinline__ void gemm_phase(PG8_LAS unsigned char* lds, const Gemm g, const Sched& S, const Epi& E) {
    const int tid = ltid(), wid = __builtin_amdgcn_readfirstlane(tid >> 6), lane = tid & 63, wr = wid >> 2, wc = wid & 3, fr = lane & 15, fq = lane >> 4;
    const int K = g.K, nt = K / BK;
    unsigned voffA[2], voffB[2];
#pragma unroll
    for (int i = 0; i < 2; ++i) { int R, C; stage_rc(tid * 16 + i * 8192, R, C); const int Rb = Epi::PERM ? ((R & ~31) + perm32(R & 31)) : R;
        voffA[i] = (unsigned)(R * K + C) * 2u; voffB[i] = (unsigned)(Rb * K + C) * 2u; }
    const size_t kstep = (size_t)(BK * 2);
    const size_t hstep = (size_t)HALF * K * 2;
    const size_t tstep = 2 * hstep;
    const unsigned ldsw = (unsigned)wid * 1024u;
    const int aoff = lds_byte(wr * 64 + fr, fq * 8), boff = lds_byte(wc * 32 + fr, fq * 8);
#define PG8_SA(b, h) (((b) * 2 + (h)) * HTB)
#define PG8_SB(b, h) ((4 + (b) * 2 + (h)) * HTB)
#define PG8_STAGE(bufoff, gbase, voff) do { _Pragma("unroll") for (int _i = 0; _i < 2; ++_i) \
        __builtin_amdgcn_global_load_lds((const unsigned*)((const char*)(gbase) + (voff)[_i]), (PG8_LAS unsigned*)(lds + (bufoff) + ldsw + _i * 8192), 16, 0, 0); } while (0)
#define PG8_LDA(dst, b, h) do { _Pragma("unroll") for (int m = 0; m < 4; ++m) _Pragma("unroll") for (int k = 0; k < 2; ++k) dst[m][k] = *(const PG8_LAS bf16x8*)(lds + PG8_SA(b, h) + aoff + m * 2048 + k * 1024); } while (0)
#define PG8_LDB(dst, b, h) do { _Pragma("unroll") for (int n = 0; n < 2; ++n) _Pragma("unroll") for (int k = 0; k < 2; ++k) dst[n][k] = *(const PG8_LAS bf16x8*)(lds + PG8_SB(b, h) + boff + n * 2048 + k * 1024); } while (0)
#define PG8_MMA(ai, bj, At, Bt) do { __builtin_amdgcn_s_setprio(1); _Pragma("unroll") for (int m = 0; m < 4; ++m) _Pragma("unroll") for (int n = 0; n < 2; ++n) _Pragma("unroll") for (int k = 0; k < 2; ++k) \
        acc[ai][bj][m][n] = __builtin_amdgcn_mfma_f32_16x16x32_bf16(Bt[n][k], At[m][k], acc[ai][bj][m][n], 0, 0, 0); __builtin_amdgcn_s_setprio(0); } while (0)
#define PG8_WAIT_V(n) asm volatile("s_waitcnt vmcnt(" #n ")" ::: "memory")
#define PG8_WAIT_L(n) asm volatile("s_waitcnt lgkmcnt(" #n ")" ::: "memory")
#define PG8_BAR __builtin_amdgcn_s_barrier()
#define PG8_SCHED __builtin_amdgcn_sched_barrier(0)
    Unit cur, nxt; int ui = 0;
    if (!S.next(0, cur)) return;
    f32x4 acc[2][2][4][2];
#pragma unroll
    for (int a = 0; a < 2; ++a)
#pragma unroll
        for (int b = 0; b < 2; ++b)
#pragma unroll
            for (int m = 0; m < 4; ++m)
#pragma unroll
                for (int n = 0; n < 2; ++n) acc[a][b][m][n] = (f32x4){0.f, 0.f, 0.f, 0.f};
    bf16x8 At[4][2], B0[2][2], B1[2][2];
    const char* cA = (const char*)g.A + (size_t)cur.pm * tstep; const char* cB = (const char*)g.Bt + (size_t)cur.pn * tstep;
    S.a_ready(cur);
    if constexpr (SP2) {
        PG8_STAGE(PG8_SB(0, 0), cB, voffB); PG8_STAGE(PG8_SB(0, 1), cB + hstep, voffB); PG8_STAGE(PG8_SA(0, 0), cA, voffA); PG8_STAGE(PG8_SA(0, 1), cA + hstep, voffA);
        if (wr == 1) PG8_BAR;
        PG8_WAIT_V(2); PG8_BAR;
        PG8_STAGE(PG8_SB(1, 0), cB + kstep, voffB); PG8_STAGE(PG8_SA(1, 0), cA + kstep, voffA); PG8_STAGE(PG8_SB(1, 1), cB + hstep + kstep, voffB);
        PG8_WAIT_V(6); PG8_BAR;
    } else {
        PG8_STAGE(PG8_SB(0, 0), cB, voffB); PG8_STAGE(PG8_SA(0, 0), cA, voffA); PG8_STAGE(PG8_SB(0, 1), cB + hstep, voffB); PG8_STAGE(PG8_SA(0, 1), cA + hstep, voffA);
        if (wr == 1) PG8_BAR;
        PG8_WAIT_V(4); PG8_BAR;
        PG8_STAGE(PG8_SB(1, 0), cB + kstep, voffB); PG8_STAGE(PG8_SA(1, 0), cA + kstep, voffA); PG8_STAGE(PG8_SB(1, 1), cB + hstep + kstep, voffB);
        PG8_WAIT_V(6); PG8_BAR;
    }
    for (;;) {
        const bool has_next = S.next(ui + 1, nxt);
        const char* nA = has_next ? (const char*)g.A + (size_t)nxt.pm * tstep : cA; const char* nB = has_next ? (const char*)g.Bt + (size_t)nxt.pn * tstep : cB;
        for (int t = 0; t < nt; t += 2) {
            const bool last = (t == nt - 2);
            const char* a1 = cA + (size_t)(t + 1) * kstep;
            const char* a2 = last ? nA : cA + (size_t)(t + 2) * kstep; const char* b2 = last ? nB : cB + (size_t)(t + 2) * kstep;
            const char* a3 = a2 + kstep; const char* b3 = b2 + kstep;
            if (last && has_next) S.a_ready(nxt);
            if constexpr (SP2) {
            PG8_LDB(B0, 0, 0); PG8_LDB(B1, 0, 1); PG8_SCHED; PG8_LDA(At, 0, 0); PG8_STAGE(PG8_SA(1, 1), a1 + hstep, voffA);
            PG8_WAIT_V(8); PG8_WAIT_L(0); PG8_BAR; PG8_MMA(0, 0, At, B0); PG8_MMA(0, 1, At, B1); PG8_BAR; PG8_SCHED;
            PG8_LDA(At, 0, 1); PG8_STAGE(PG8_SB(0, 0), b2, voffB); PG8_STAGE(PG8_SB(0, 1), b2 + hstep, voffB); PG8_STAGE(PG8_SA(0, 0), a2, voffA);
            PG8_WAIT_V(8); PG8_WAIT_L(0); PG8_BAR; PG8_MMA(1, 0, At, B0); PG8_MMA(1, 1, At, B1); PG8_BAR; PG8_SCHED;
            PG8_LDB(B0, 1, 0); PG8_LDB(B1, 1, 1); PG8_SCHED; PG8_LDA(At, 1, 0); PG8_STAGE(PG8_SA(0, 1), a2 + hstep, voffA);
            PG8_WAIT_V(8); PG8_WAIT_L(0); PG8_BAR; PG8_MMA(0, 0, At, B0); PG8_MMA(0, 1, At, B1); PG8_BAR; PG8_SCHED;
            PG8_LDA(At, 1, 1); PG8_STAGE(PG8_SB(1, 0), b3, voffB); PG8_STAGE(PG8_SB(1, 1), b3 + hstep, voffB); PG8_STAGE(PG8_SA(1, 0), a3, voffA);
            PG8_WAIT_V(8); PG8_WAIT_L(0); PG8_BAR; PG8_MMA(1, 0, At, B0); PG8_MMA(1, 1, At, B1); PG8_BAR; PG8_SCHED;
            } else {
            PG8_LDB(B0, 0, 0); PG8_SCHED; PG8_LDA(At, 0, 0); PG8_STAGE(PG8_SA(1, 1), a1 + hstep, voffA);
            PG8_WAIT_L(8); PG8_BAR; PG8_WAIT_L(0); PG8_MMA(0, 0, At, B0); PG8_BAR; PG8_SCHED;
            PG8_LDB(B1, 0, 1); PG8_STAGE(PG8_SB(0, 0), b2, voffB);
            PG8_BAR; PG8_WAIT_L(0); PG8_MMA(0, 1, At, B1); PG8_BAR;
            PG8_LDA(At, 0, 1); PG8_STAGE(PG8_SA(0, 0), a2, voffA);
            PG8_BAR; PG8_WAIT_L(0); PG8_MMA(1, 0, At, B0); PG8_BAR; PG8_SCHED;
            PG8_STAGE(PG8_SB(0, 1), b2 + hstep, voffB);
            PG8_WAIT_V(6); PG8_BAR; PG8_MMA(1, 1, At, B1); PG8_BAR;
            PG8_LDB(B0, 1, 0); PG8_SCHED; PG8_LDA(At, 1, 0); PG8_STAGE(PG8_SA(0, 1), a2 + hstep, voffA);
            PG8_WAIT_L(8); PG8_BAR; PG8_WAIT_L(0); PG8_MMA(0, 0, At, B0); PG8_BAR; PG8_SCHED;
            PG8_LDB(B1, 1, 1); PG8_STAGE(PG8_SB(1, 0), b3, voffB);
            PG8_BAR; PG8_WAIT_L(0); PG8_MMA(0, 1, At, B1); PG8_BAR;
            PG8_LDA(At, 1, 1); PG8_STAGE(PG8_SA(1, 0), a3, voffA);
            PG8_BAR; PG8_WAIT_L(0); PG8_MMA(1, 0, At, B0); PG8_BAR; PG8_SCHED;
            PG8_STAGE(PG8_SB(1, 1), b3 + hstep, voffB);
            PG8_WAIT_V(6); PG8_BAR; PG8_MMA(1, 1, At, B1); PG8_BAR;
            }
        }
        if constexpr (ALIGN_EPI) { if (wr == 0) PG8_BAR; }
        if constexpr (!Epi::AFTER_DRAIN) { E(acc, cur, wr, wc, fr, fq); S.done(cur); }
        if (!has_next) break;
#pragma unroll
        for (int a = 0; a < 2; ++a)
#pragma unroll
            for (int b = 0; b < 2; ++b)
#pragma unroll
                for (int m = 0; m < 4; ++m)
#pragma unroll
                    for (int n = 0; n < 2; ++n) acc[a][b][m][n] = (f32x4){0.f, 0.f, 0.f, 0.f};
        cur = nxt; cA = nA; cB = nB; ++ui;
        if constexpr (ALIGN_EPI) { if (wr == 1) PG8_BAR; }
    }
    PG8_WAIT_V(0);
    if constexpr (!ALIGN_EPI) { if (wr == 0) PG8_BAR; }
    PG8_BAR;
    if constexpr (Epi::AFTER_DRAIN) { E.fused(acc, cur, wr, wc, fr, fq, lds, wid, lane); S.done(cur); }
#undef PG8_SA
#undef PG8_SB
#undef PG8_STAGE
#undef PG8_LDA
#undef PG8_LDB
#undef PG8_MMA
#undef PG8_WAIT_V
#undef PG8_WAIT_L
#undef PG8_BAR
#undef PG8_SCHED
}
}
namespace attn_body {
using bf16=__hip_bfloat16;
using bf16x8=__attribute__((ext_vector_type(8)))short;
using s16x4=__attribute__((ext_vector_type(4)))short;
using f32x16=__attribute__((ext_vector_type(16)))float;
using u32x4=__attribute__((ext_vector_type(4)))unsigned;
constexpr int D=64,QP=512,KP=128;
constexpr int NW=8,QBLK=32,QB=QBLK*NW,KVBLK=64;

__device__ __forceinline__ int crow(int r,int hi){return (r&3)+8*(r>>2)+4*hi;}
#define SBAR() __builtin_amdgcn_sched_barrier(0)
__device__ __forceinline__ void cmask(f32x16&p0,f32x16&p1,int jb,int qrel,int hi){
  const float NEG=-INFINITY; int kb=64*jb+4*hi;
  #pragma unroll
  for(int r=0;r<16;++r){int kv=kb+(r&3)+8*(r>>2); if(kv>qrel)p0[r]=NEG; if(kv+32>qrel)p1[r]=NEG;}
}

constexpr int NSLOT=3, SLOTB=8192;
constexpr int LDS_K=0, LDS_V=NSLOT*SLOTB, LDS_WS=2*NSLOT*SLOTB, LDS_OST=LDS_WS+NW*64*4, LDS_BYTES=LDS_OST+NW*4096;
constexpr float C2=0.125f*1.4426950408889634f;
__device__ __forceinline__ void glds16(const void*gsrc,unsigned lds_dst){unsigned keep;
  asm volatile("s_mov_b32 %0, m0\n\ts_mov_b32 m0, %2\n\ts_nop 0\n\tglobal_load_lds_dwordx4 %1, off\n\ts_mov_b32 m0, %0":"=&s"(keep):"v"(gsrc),"s"(lds_dst):"memory");}
__device__ __forceinline__ float max3f(float a,float b,float c){float r;asm("v_max3_f32 %0, %1, %2, %3":"=v"(r):"v"(a),"v"(b),"v"(c));return r;}
__device__ __forceinline__ float max2f(float a,float b){float r;asm("v_max_f32_e32 %0, %1, %2":"=v"(r):"v"(a),"v"(b));return r;}
__device__ __forceinline__ float fadd_s(float a,float b){float r;asm("v_add_f32_e32 %0, %1, %2":"=v"(r):"v"(a),"v"(b));return r;}
__device__ __forceinline__ float fsub_s(float a,float b){float r;asm("v_sub_f32_e32 %0, %1, %2":"=v"(r):"v"(a),"v"(b));return r;}
typedef float f32x2_t __attribute__((ext_vector_type(2))); typedef __bf16 bf16x2_t __attribute__((ext_vector_type(2)));
__device__ __forceinline__ unsigned cvtpk_s(float lo,float hi){f32x2_t v={lo,hi};bf16x2_t b=__builtin_convertvector(v,bf16x2_t);return __builtin_bit_cast(unsigned,b);}
#define WAIT_BAR(N) asm volatile("s_waitcnt vmcnt(" #N ") lgkmcnt(0)\n\ts_barrier":::"memory")

__device__ __forceinline__ void qkt(f32x16&p0,f32x16&p1,const char*Kslot,const bf16x8*qr,const f32x16&negm,int r32,int hi){
  const char*kb=Kslot+hi*1024+r32*16;
  #pragma unroll
  for(int d0=0;d0<4;++d0){
    const bf16x8 b0=*reinterpret_cast<const bf16x8*>(kb+d0*2048);
    const bf16x8 b1=*reinterpret_cast<const bf16x8*>(kb+d0*2048+512);
    if(d0==0){p0=__builtin_amdgcn_mfma_f32_32x32x16_bf16(b0,qr[0],negm,0,0,0);p1=__builtin_amdgcn_mfma_f32_32x32x16_bf16(b1,qr[0],negm,0,0,0);}
    else{p0=__builtin_amdgcn_mfma_f32_32x32x16_bf16(b0,qr[d0],p0,0,0,0);p1=__builtin_amdgcn_mfma_f32_32x32x16_bf16(b1,qr[d0],p1,0,0,0);}}
}
typedef __attribute__((address_space(3))) const char* lds_cptr;
typedef short v4i16_t __attribute__((ext_vector_type(4)));
__device__ __forceinline__ void kload8(bf16x8*kf,lds_cptr kp){
  kf[0]=*(const __attribute__((address_space(3))) bf16x8*)(kp);      kf[1]=*(const __attribute__((address_space(3))) bf16x8*)(kp+512);
  kf[2]=*(const __attribute__((address_space(3))) bf16x8*)(kp+2048); kf[3]=*(const __attribute__((address_space(3))) bf16x8*)(kp+2560);
  kf[4]=*(const __attribute__((address_space(3))) bf16x8*)(kp+4096); kf[5]=*(const __attribute__((address_space(3))) bf16x8*)(kp+4608);
  kf[6]=*(const __attribute__((address_space(3))) bf16x8*)(kp+6144); kf[7]=*(const __attribute__((address_space(3))) bf16x8*)(kp+6656);
}
__device__ __forceinline__ void kload2(bf16x8*kf,lds_cptr kp,int j){ kf[2*j]=*(const __attribute__((address_space(3))) bf16x8*)(kp+j*2048); kf[2*j+1]=*(const __attribute__((address_space(3))) bf16x8*)(kp+j*2048+512); }
__device__ __forceinline__ s16x4 vtr(lds_cptr p){ return __builtin_bit_cast(s16x4,__builtin_amdgcn_ds_read_tr16_b64_v4i16((__attribute__((address_space(3))) v4i16_t*)p)); }
__device__ __forceinline__ float rowmax(const f32x16&p0,const f32x16&p1){
  float a=max3f(p0[0],p0[1],p1[0]),b=max3f(p0[2],p0[3],p1[1]);a=max3f(a,p1[2],p1[3]);
  #pragma unroll
  for(int r=4;r<16;r+=4){a=max3f(a,p0[r],p0[r+1]);b=max3f(b,p0[r+2],p0[r+3]);a=max3f(a,p1[r],p1[r+1]);b=max3f(b,p1[r+2],p1[r+3]);}
  const float m=max2f(a,b);
  auto rr=__builtin_amdgcn_permlane32_swap(__float_as_uint(m),__float_as_uint(m),false,false);
  return max2f(__uint_as_float(rr[0]),__uint_as_float(rr[1]));
}
__device__ __forceinline__ void pv(f32x16*o,int vb,bf16x8 pa0,bf16x8 pa1,bf16x8 pa2,bf16x8 pa3){
  #pragma unroll
  for(int d0=0;d0<2;++d0){s16x4 lo[4],hi[4];
    #pragma unroll
    for(int ks=0;ks<4;++ks){
      asm volatile("ds_read_b64_tr_b16 %0,%1 offset:%c2":"=&v"(lo[ks]):"v"(vb),"i"(d0*4096+ks*1024):"memory");
      asm volatile("ds_read_b64_tr_b16 %0,%1 offset:%c2":"=&v"(hi[ks]):"v"(vb),"i"(d0*4096+ks*1024+512):"memory");}
    asm volatile("s_waitcnt lgkmcnt(0)":::"memory");SBAR();
    #define PK(k) (bf16x8){lo[k][0],lo[k][1],lo[k][2],lo[k][3],hi[k][0],hi[k][1],hi[k][2],hi[k][3]}
    o[d0]=__builtin_amdgcn_mfma_f32_32x32x16_bf16(pa0,PK(0),o[d0],0,0,0);
    o[d0]=__builtin_amdgcn_mfma_f32_32x32x16_bf16(pa1,PK(1),o[d0],0,0,0);
    o[d0]=__builtin_amdgcn_mfma_f32_32x32x16_bf16(pa2,PK(2),o[d0],0,0,0);
    o[d0]=__builtin_amdgcn_mfma_f32_32x32x16_bf16(pa3,PK(3),o[d0],0,0,0);
    #undef PK
  }
}

#ifndef ATTN_STORE16
#define ATTN_STORE16(p,v) (*(u32x4*)(p)=(v))
#endif
template<int THRL> __device__ __forceinline__ void attn_unit(long rowbase,int T,int h,int qb,const bf16*Q,const bf16*__restrict__ K,const bf16*__restrict__ V,bf16*O,char*shm){
  const int tid=ltid(),lane=tid&63,r32=lane&31,hi=lane>>5; const int wid=__builtin_amdgcn_readfirstlane(tid>>6);
  const int q0=qb*QB;
  const bf16*Qw=Q+(rowbase+q0+wid*QBLK)*QP+h*D;
  const bf16*Kh=K+rowbase*KP+(h>>2)*D,*Vh=V+rowbase*KP+(h>>2)*D;
  const unsigned lds0=(unsigned)(uintptr_t)shm;
  float*wsf=(float*)(shm+LDS_WS)+wid*64;
  const bf16*ksrc=Kh+(long)lane*KP+wid*8;
  const bf16*vsrc=Vh+(long)(16*(wid&3)+(lane>>2))*KP+(wid>>2)*32+(lane&3)*8;
  const unsigned kdst=lds0+LDS_K+wid*1024, vdst=lds0+LDS_V+wid*1024;
  #define DMA_K(t,slot) glds16(ksrc+(long)(t)*KVBLK*KP,(unsigned)__builtin_amdgcn_readfirstlane(kdst+(slot)))
  #define DMA_V(t,slot) glds16(vsrc+(long)(t)*KVBLK*KP,(unsigned)__builtin_amdgcn_readfirstlane(vdst+(slot)))
  const int vb0=(int)(lds0+LDS_V)+((lane>>4)&1)*32+(lane&3)*8+(4*hi+((lane&15)>>2))*64;
  const char*Kbase=shm+LDS_K; bf16x8 kf[8];
  const lds_cptr shm3=(lds_cptr)shm; const lds_cptr kp0=shm3+LDS_K+hi*1024+r32*16; const lds_cptr vp0=shm3+LDS_V+((lane>>4)&1)*32+(lane&3)*8+(4*hi+((lane&15)>>2))*64;
  const int NT=T/KVBLK;
  DMA_K(0,0);DMA_V(0,0);DMA_K(1,SLOTB);
  bf16x8 qr[4];
  #pragma unroll
  for(int d0=0;d0<4;++d0)qr[d0]=*reinterpret_cast<const bf16x8*>(&Qw[(long)r32*QP+d0*16+hi*8]);
  float mhat=0.f,l_reg=0.f;f32x16 o[2];o[0]=f32x16{};o[1]=f32x16{};f32x16 negm=f32x16{};asm volatile("":"+v"(negm));
  const int qrel=wid*QBLK+r32;
  #define CMASK(P0,P1,t) do{}while(0)
  bool resc=false;
  #define START(P0,P1) do{ const float rm=rowmax(P0,P1); resc=false; \
    { const float dl=rm; mhat=fadd_s(mhat,dl); \
      _Pragma("unroll") for(int r=0;r<16;++r){P0[r]=fsub_s(P0[r],dl);P1[r]=fsub_s(P1[r],dl);} \
      _Pragma("unroll") for(int r=0;r<16;++r)negm[r]=-mhat; asm volatile("":"+v"(negm)); } \
    _Pragma("unroll") for(int r=0;r<16;++r)P0[r]=__builtin_amdgcn_exp2f(P0[r]); }while(0)
  #define RESC() do{ if(resc){ asm volatile("s_waitcnt lgkmcnt(0)":::"memory"); \
      _Pragma("unroll") for(int d_=0;d_<2;++d_) _Pragma("unroll") for(int r=0;r<16;++r)o[d_][r]*=wsf[crow(r,hi)]; } }while(0)
  f32x16 pA0,pA1,pB0,pB1;
  int sl_prev=0,sl_cur=0,sl_next=SLOTB;
  #define ROT() do{sl_prev=sl_cur;sl_cur=sl_next;sl_next=(sl_next==(NSLOT-1)*SLOTB)?0:sl_next+SLOTB;}while(0)
  DMA_K(2,2*SLOTB);
  WAIT_BAR(3);
  qkt(pA0,pA1,Kbase,qr,negm,r32,hi);asm volatile("s_nop 15\n\ts_nop 7":"+v"(pA0),"+v"(pA1));CMASK(pA0,pA1,0);
  START(pA0,pA1);
  _Pragma("unroll") for(int r=0;r<16;++r)pA1[r]=__builtin_amdgcn_exp2f(pA1[r]);
  WAIT_BAR(0);
  DMA_K(3,0);DMA_V(1,SLOTB);
  ROT();
  kload8(kf,kp0+sl_cur);
  WAIT_BAR(2);
  s16x4 vlo[8],vhi[8]; u32x4 pw0,pw1,pw2,pw3;
  #define PKW(P,B) cvtpk_s(P[B],P[B+1])
  #define PAF(k) __builtin_bit_cast(bf16x8,pw##k)
  #define VFR(i) (bf16x8){vlo[i][0],vlo[i][1],vlo[i][2],vlo[i][3],vhi[i][0],vhi[i][1],vhi[i][2],vhi[i][3]}
  #define PIN(x) asm volatile("":"+v"(x))
  #define MX3(a,b,c) __builtin_fmaxf(__builtin_fmaxf((a),(b)),(c))
  #define GAPA(MF,A0,A1,A2,A3,W0,W1,PW) do{ MF; sacc+=A0; sacc+=A1; sacc+=A2; sacc+=A3; PIN(sacc); W0; W1; PIN(PW); SBAR(); }while(0)
  #define EX(v) __builtin_amdgcn_exp2f(v)
  #define GAPB(MF,X,B) do{ MF; X[B]=EX(X[B]); X[B+1]=EX(X[B+1]); X[B+2]=EX(X[B+2]); X[B+3]=EX(X[B+3]); PIN(X); SBAR(); }while(0)
  #define VRD(i) do{ vlo[i]=vtr(vp_+(((i)>>2)*4096+((i)&3)*1024)); vhi[i]=vtr(vp_+(((i)>>2)*4096+((i)&3)*1024+512)); }while(0)
  #define KRD(G,j) do{ if(G){ kload2(kf,kp0+sl_next,j); SBAR(); } }while(0)
  #define STEP(C0,C1,P0,P1,t,GK,GV,GL) do{ SBAR(); \
    const lds_cptr vp_=vp0+sl_prev; \
    VRD(0); SBAR(); float sacc=(P0[0]+P0[1]); \
    GAPA(C0=__builtin_amdgcn_mfma_f32_32x32x16_bf16(kf[0],qr[0],negm,0,0,0), P0[2],P0[3],P0[4],P0[5],     pw0[0]=PKW(P0,0), pw0[1]=PKW(P0,2), pw0); \
    VRD(4); SBAR(); GAPA(C1=__builtin_amdgcn_mfma_f32_32x32x16_bf16(kf[1],qr[0],negm,0,0,0), P0[6],P0[7],P0[8],P0[9],     pw0[2]=PKW(P0,4), pw0[3]=PKW(P0,6), pw0); \
    VRD(1); SBAR(); GAPA(C0=__builtin_amdgcn_mfma_f32_32x32x16_bf16(kf[2],qr[1],C0,0,0,0),   P0[10],P0[11],P0[12],P0[13], pw1[0]=PKW(P0,8), pw1[1]=PKW(P0,10), pw1); \
    VRD(5); SBAR(); GAPA(C1=__builtin_amdgcn_mfma_f32_32x32x16_bf16(kf[3],qr[1],C1,0,0,0),   P0[14],P0[15],P1[0],P1[1],   pw1[2]=PKW(P0,12),pw1[3]=PKW(P0,14), pw1); \
    VRD(2); SBAR(); GAPA(C0=__builtin_amdgcn_mfma_f32_32x32x16_bf16(kf[4],qr[2],C0,0,0,0),   P1[2],P1[3],P1[4],P1[5],     pw2[0]=PKW(P1,0), pw2[1]=PKW(P1,2), pw2); \
    VRD(6); SBAR(); GAPA(C1=__builtin_amdgcn_mfma_f32_32x32x16_bf16(kf[5],qr[2],C1,0,0,0),   P1[6],P1[7],P1[8],P1[9],     pw2[2]=PKW(P1,4), pw2[3]=PKW(P1,6), pw2); \
    VRD(3); SBAR(); GAPA(C0=__builtin_amdgcn_mfma_f32_32x32x16_bf16(kf[6],qr[3],C0,0,0,0),   P1[10],P1[11],P1[12],P1[13], pw3[0]=PKW(P1,8), pw3[1]=PKW(P1,10), pw3); \
    VRD(7); SBAR(); GAPA(C1=__builtin_amdgcn_mfma_f32_32x32x16_bf16(kf[7],qr[3],C1,0,0,0),   P1[14],P1[15],0.f,0.f,       pw3[2]=PKW(P1,12),pw3[3]=PKW(P1,14), pw3); \
    l_reg+=sacc; \
    if(GK){DMA_K((t)+3,sl_cur);} if(GV){DMA_V((t)+1,sl_next);} \
    CMASK(C0,C1,t); \
    { float a=MX3(C0[0],C0[1],C1[0]),b=MX3(C0[2],C0[3],C1[1]); a=MX3(a,C1[2],C1[3]); \
      _Pragma("unroll") for(int r=4;r<16;r+=4){a=MX3(a,C0[r],C0[r+1]);b=MX3(b,C0[r+2],C0[r+3]);a=MX3(a,C1[r],C1[r+1]);b=MX3(b,C1[r+2],C1[r+3]);} \
      float rm=__builtin_fmaxf(a,b); { auto rr=__builtin_amdgcn_permlane32_swap(__float_as_uint(rm),__float_as_uint(rm),false,false); rm=__builtin_fmaxf(__uint_as_float(rr[0]),__uint_as_float(rr[1])); } \
      resc=false; \
      if(__builtin_expect(__any(rm>(float)THRL),0)){ const float dl=__builtin_fmaxf(rm,0.f); mhat+=dl; \
        _Pragma("unroll") for(int r=0;r<16;++r){C0[r]-=dl;C1[r]-=dl;} \
        _Pragma("unroll") for(int r=0;r<16;++r)negm[r]=-mhat; asm volatile("":"+v"(negm)); \
        const float f=__builtin_amdgcn_exp2f(-dl); l_reg*=f; if(hi==0)wsf[r32]=f; resc=true; } } \
    SBAR(); \
    GAPB(o[0]=__builtin_amdgcn_mfma_f32_32x32x16_bf16(PAF(0),VFR(0),o[0],0,0,0), C0,0); \
    GAPB(o[1]=__builtin_amdgcn_mfma_f32_32x32x16_bf16(PAF(0),VFR(4),o[1],0,0,0), C0,4); \
    KRD(GL,0); GAPB(o[0]=__builtin_amdgcn_mfma_f32_32x32x16_bf16(PAF(1),VFR(1),o[0],0,0,0), C0,8); \
    KRD(GL,1); GAPB(o[1]=__builtin_amdgcn_mfma_f32_32x32x16_bf16(PAF(1),VFR(5),o[1],0,0,0), C0,12); \
    KRD(GL,2); GAPB(o[0]=__builtin_amdgcn_mfma_f32_32x32x16_bf16(PAF(2),VFR(2),o[0],0,0,0), C1,0); \
    KRD(GL,3); GAPB(o[1]=__builtin_amdgcn_mfma_f32_32x32x16_bf16(PAF(2),VFR(6),o[1],0,0,0), C1,4); \
    GAPB(o[0]=__builtin_amdgcn_mfma_f32_32x32x16_bf16(PAF(3),VFR(3),o[0],0,0,0), C1,8); \
    GAPB(o[1]=__builtin_amdgcn_mfma_f32_32x32x16_bf16(PAF(3),VFR(7),o[1],0,0,0), C1,12); \
    }while(0)
  int t=1;
  #undef CMASK
  #define CMASK(P0,P1,t) do{}while(0)
  for(;t+5<NT;t+=2){
    STEP(pB0,pB1,pA0,pA1,t,true,true,true);     WAIT_BAR(2); RESC(); ROT();
    STEP(pA0,pA1,pB0,pB1,t+1,true,true,true);   WAIT_BAR(2); RESC(); ROT();
  }
  #undef CMASK
  #define CMASK(P0,P1,t) do{}while(0)
  #define ENDW(tt) do{ if((tt)+3<NT){WAIT_BAR(2);} else if((tt)+2<NT){WAIT_BAR(1);} else {WAIT_BAR(0);} }while(0)
  for(;t+1<NT;t+=2){
    STEP(pB0,pB1,pA0,pA1,t,(t+3<NT),(t+1<NT),(t+1<NT));       ENDW(t);   RESC(); ROT();
    STEP(pA0,pA1,pB0,pB1,t+1,(t+4<NT),(t+2<NT),(t+2<NT));     ENDW(t+1); RESC(); ROT();
  }
  STEP(pB0,pB1,pA0,pA1,NT-1,false,false,false); RESC();
  { float sacc=pB0[0]+pB0[1]; _Pragma("unroll") for(int r=2;r<16;++r)sacc+=pB0[r]; _Pragma("unroll") for(int r=0;r<16;++r)sacc+=pB1[r]; l_reg+=sacc;
    pw0=(u32x4){PKW(pB0,0),PKW(pB0,2),PKW(pB0,4),PKW(pB0,6)};pw1=(u32x4){PKW(pB0,8),PKW(pB0,10),PKW(pB0,12),PKW(pB0,14)};pw2=(u32x4){PKW(pB1,0),PKW(pB1,2),PKW(pB1,4),PKW(pB1,6)};pw3=(u32x4){PKW(pB1,8),PKW(pB1,10),PKW(pB1,12),PKW(pB1,14)};
    SBAR(); pv(o,vb0+sl_cur,PAF(0),PAF(1),PAF(2),PAF(3)); }
  #undef PKW
  #undef PAF
  #undef VFR
  #undef PIN
  #undef MX3
  #undef GAPA
  #undef GAPB
  #undef EX
  #undef VRD
  #undef KRD
  #undef STEP
  #undef ENDW
  {auto rr=__builtin_amdgcn_permlane32_swap(__float_as_uint(l_reg),__float_as_uint(l_reg),false,false);l_reg=__uint_as_float(rr[0])+__uint_as_float(rr[1]);}
  if(hi==0)wsf[32+r32]=l_reg;asm volatile("s_waitcnt lgkmcnt(0)":::"memory");
  float rli[16];
  #pragma unroll
  for(int r=0;r<16;++r)rli[r]=__builtin_amdgcn_rcpf(wsf[32+crow(r,hi)]);
  bf16*Ow=O+(rowbase+q0+wid*QBLK)*QP+h*D;
  { bf16*stg=(bf16*)(shm+LDS_OST)+wid*2048;
    #pragma unroll
    for(int r=0;r<16;++r){const int orow=crow(r,hi);
      #pragma unroll
      for(int d0=0;d0<2;++d0)stg[orow*64+d0*32+r32]=__float2bfloat16(o[d0][r]*rli[r]);}
    asm volatile("s_waitcnt lgkmcnt(0)":::"memory");
    #pragma unroll
    for(int i=0;i<4;++i){const int row=i*8+(lane>>3),ch=lane&7; const u32x4 v=*(const u32x4*)(stg+row*64+ch*8); ATTN_STORE16(Ow+(long)row*QP+ch*8,v);} }
  asm volatile("s_waitcnt lgkmcnt(0)\n\ts_barrier":::"memory");
  #undef DMA_K
  #undef DMA_V
  #undef CMASK
  #undef START
  #undef RESC
  #undef ROT
}
constexpr int ATTN_LDS_BYTES=LDS_BYTES;
#undef SBAR
#undef WAIT_BAR
}
#define LAS __attribute__((address_space(3)))
typedef unsigned short bf16;
typedef unsigned v4u __attribute__((ext_vector_type(4)));
typedef unsigned v2u __attribute__((ext_vector_type(2)));
typedef float v4f __attribute__((ext_vector_type(4)));
typedef float v2f __attribute__((ext_vector_type(2)));
typedef short h8 __attribute__((ext_vector_type(8)));
typedef short s4 __attribute__((ext_vector_type(4)));

constexpr int NTHR = 512, NWAVES = 8;
constexpr int DMOD = 1024, MB = 16384, NBATCH = 3, NPROJ = 5888, DFF = 2816;
constexpr int LDS_BYTES = 147456;
constexpr size_t MiB = 1u << 20;
constexpr size_t WS_TAB64 = 1 * MiB, WS_TAB128 = 1 * MiB + 65536;
constexpr size_t WS_WIN = 2 * MiB, WS_WBA = 14 * MiB, WS_WBR = 15 * MiB, WS_WOUT = 17 * MiB, WS_WFI = 19 * MiB, WS_WFO = 30 * MiB;
constexpr size_t WS_SS1 = 36 * MiB, WS_SS2 = 37 * MiB;
constexpr size_t WS_XN = 40 * MiB;
constexpr size_t WS_PROJ = 136 * MiB;
constexpr size_t WS_QA = 320 * MiB, WS_KA = 336 * MiB, WS_VA = 340 * MiB, WS_QR = 344 * MiB, WS_KR = 360 * MiB, WS_RET = 376 * MiB;
constexpr size_t WS_ST = 408 * MiB;
constexpr size_t WS_MIX = 408 * MiB, WS_X1B = 440 * MiB, WS_END = 472 * MiB;

__device__ __forceinline__ unsigned f2bf(float f) { unsigned u = __builtin_bit_cast(unsigned, f); return (u + 0x7fffu + ((u >> 16) & 1u)) >> 16; }
__device__ __forceinline__ unsigned pk2(float lo, float hi) { return f2bf(lo) | (f2bf(hi) << 16); }
__device__ __forceinline__ float blo(unsigned u) { return __uint_as_float(u << 16); }
__device__ __forceinline__ float bhi(unsigned u) { return __uint_as_float(u & 0xffff0000u); }
__device__ __forceinline__ float bfs(short s) { return __uint_as_float(((unsigned)(unsigned short)s) << 16); }
__device__ __forceinline__ float wave_sum(float v) {
#pragma unroll
    for (int o = 1; o < 64; o <<= 1) v += __shfl_xor(v, o);
    return v;
}
__device__ __forceinline__ s4 tr_read(LAS const unsigned char* p) { return __builtin_bit_cast(s4, __builtin_amdgcn_ds_read_tr16_b64_v4i16((LAS s4*)p)); }
__device__ __forceinline__ float log2_gamma(float z) { return -log1pf(expf(-z)) * 1.4426950408889634f; }

__device__ __forceinline__ void transpose_item(const float* W, int K, int N, bf16* WT, LAS float* scr, int item, int lane, const float* kscale, int mode) {
    const int nblk = N / 32, kb = item / nblk, nb = item % nblk, k0 = 64 * kb, n0 = 32 * nb;
    int d0 = n0;
    if (mode == 1) { const int bj = n0 / DFF, rem = n0 - bj * DFF; d0 = 256 * (rem / 128) + 128 * bj + (rem % 128); }
#pragma unroll 8
    for (int i = 0; i < 32; ++i) { const int kk = 2 * i + (lane >> 5); float v = W[(size_t)(k0 + kk) * N + n0 + (lane & 31)]; if (kscale) v *= kscale[k0 + kk]; scr[kk * 33 + (lane & 31)] = v; }
    asm volatile("s_waitcnt lgkmcnt(0)" ::: "memory");
    const int c = lane & 7;
#pragma unroll
    for (int j = 0; j < 4; ++j) { const int n = (lane >> 3) + 8 * j; const LAS float* s = scr + (8 * c) * 33 + n;
        v4u o; o.x = pk2(s[0 * 33], s[1 * 33]); o.y = pk2(s[2 * 33], s[3 * 33]); o.z = pk2(s[4 * 33], s[5 * 33]); o.w = pk2(s[6 * 33], s[7 * 33]);
        *(v4u*)(WT + (size_t)(d0 + n) * K + k0 + 8 * c) = o; }
    asm volatile("s_waitcnt lgkmcnt(0)" ::: "memory");
}
__device__ __forceinline__ void rms_row_bf16(const float* xrow, const float* gain, bf16* orow, int lane) {
    const v4f* xr = (const v4f*)xrow + lane; const v4f* gr = (const v4f*)gain + lane;
    v4f v[4]; float s = 0.f;
#pragma unroll
    for (int j = 0; j < 4; ++j) { v[j] = xr[64 * j]; s += (v[j].x * v[j].x + v[j].y * v[j].y) + (v[j].z * v[j].z + v[j].w * v[j].w); }
    const float rstd = rsqrtf(wave_sum(s) * (1.f / DMOD) + 1e-6f);
    v2u* o8 = (v2u*)orow + lane;
#pragma unroll
    for (int j = 0; j < 4; ++j) { const v4f g = gr[64 * j]; v2u o; o.x = pk2(v[j].x * rstd * g.x, v[j].y * rstd * g.y); o.y = pk2(v[j].z * rstd * g.z, v[j].w * rstd * g.w); o8[64 * j] = o; }
}
__device__ __forceinline__ void final_norm_rows(float* out, const float* ss, const float* gain, int gw, int NGW, int lane) {
    for (int m = gw; m < MB; m += NGW) {
        float p = (lane < 16) ? ss[(size_t)m * 16 + lane] : 0.f;
        const float rstd = rsqrtf(wave_sum(p) * (1.f / DMOD) + 1e-6f);
        v4f* xr = (v4f*)(out + (size_t)m * DMOD) + lane; const v4f* gr = (const v4f*)gain + lane;
#pragma unroll
        for (int j = 0; j < 4; ++j) { v4f v = xr[64 * j]; const v4f g = gr[64 * j]; v.x *= rstd * g.x; v.y *= rstd * g.y; v.z *= rstd * g.z; v.w *= rstd * g.w; xr[64 * j] = v; }
    }
}

__device__ __forceinline__ void rope8(float (&v)[8], const v2f* tb, float scale, v4u& o) {
    float r[8];
#pragma unroll
    for (int p = 0; p < 4; ++p) { const v2f cs = tb[p]; const float x0 = v[2 * p], x1 = v[2 * p + 1]; r[2 * p] = (x0 * cs.x - x1 * cs.y) * scale; r[2 * p + 1] = (x0 * cs.y + x1 * cs.x) * scale; }
    o.x = pk2(r[0], r[1]); o.y = pk2(r[2], r[3]); o.z = pk2(r[4], r[5]); o.w = pk2(r[6], r[7]);
}
__device__ __forceinline__ void unpack8(const v4u raw, float (&v)[8]) { v[0] = blo(raw.x); v[1] = bhi(raw.x); v[2] = blo(raw.y); v[3] = bhi(raw.y); v[4] = blo(raw.z); v[5] = bhi(raw.z); v[6] = blo(raw.w); v[7] = bhi(raw.w); }
__device__ __forceinline__ void prep_rows(int T, const bf16* PROJ, bf16* QA, bf16* KA, bf16* VA, bf16* QR, bf16* KR, const float* qn, const float* kn,
                                          const v2f* tab64, const v2f* tab128, int gw, int NGW, int lane) {
    const float C2 = 0.125f * 1.4426950408889634f;
    for (int m = gw; m < MB; m += NGW) {
        const int t = m & (T - 1); const int prow = t >> 6, pcol = t & 63;
        const bf16* pr = PROJ + (size_t)m * NPROJ;
        const int l8 = lane & 7, l16 = lane & 15;
        const v2f* tb64 = tab64 + ((l8 < 4) ? prow : pcol) * 16 + ((4 * l8) & 15);
        const v2f* tb128 = tab128 + ((l16 < 8) ? prow : pcol) * 32 + ((4 * l16) & 31);
        {
            float v[8]; unpack8(*(const v4u*)(pr + 8 * lane), v); float ss = 0.f;
#pragma unroll
            for (int e = 0; e < 8; ++e) ss += v[e] * v[e];
            ss += __shfl_xor(ss, 1); ss += __shfl_xor(ss, 2); ss += __shfl_xor(ss, 4);
            const float rstd = rsqrtf(ss * (1.f / 64.f) + 1e-6f);
#pragma unroll
            for (int e = 0; e < 8; ++e) v[e] *= rstd * qn[8 * l8 + e];
            v4u o; rope8(v, tb64, C2, o); *(v4u*)(QA + (size_t)m * 512 + 8 * lane) = o;
        }
        {
            const int ll = lane & 31; const v4u raw = *(const v4u*)(pr + 512 + 8 * ll);
            float v[8]; unpack8(raw, v); float ss = 0.f;
#pragma unroll
            for (int e = 0; e < 8; ++e) ss += v[e] * v[e];
            ss += __shfl_xor(ss, 1); ss += __shfl_xor(ss, 2); ss += __shfl_xor(ss, 4);
            const float rstd = rsqrtf(ss * (1.f / 64.f) + 1e-6f);
#pragma unroll
            for (int e = 0; e < 8; ++e) v[e] *= rstd * kn[8 * l8 + e];
            v4u o; rope8(v, tb64, 1.0f, o);
            if (lane < 16) *(v4u*)(KA + (size_t)m * 128 + 8 * lane) = o;
            else if (lane < 32) *(v4u*)(VA + (size_t)m * 128 + 8 * (lane - 16)) = raw;
        }
        {
            float v[8]; unpack8(*(const v4u*)(pr + 768 + 8 * lane), v);
            v4u o; rope8(v, tb128, 0.08838834764831845f, o); *(v4u*)(QR + (size_t)m * 512 + 8 * lane) = o;
        }
        {
            float v[8]; unpack8(*(const v4u*)(pr + 1280 + 8 * lane), v);
            v4u o; rope8(v, tb128, 1.0f, o); *(v4u*)(KR + (size_t)m * 512 + 8 * lane) = o;
        }
    }
}

__device__ __forceinline__ void ret_kv_unit(LAS unsigned char* L, const bf16* KR, const bf16* PROJ, bf16* ST, int cgi, int h, float lgf2, float lgb2) {
    const int tid = ltid(), lane = tid & 63, w = tid >> 6, g = lane >> 4, c = lane & 15, q = c >> 2, p = lane & 3;
    const int row0 = cgi * 128;
    constexpr int PK = 288, PV = 544, VOFF = 128 * PK;
#pragma unroll
    for (int i = 0; i < 4; ++i) { const int id = tid + 512 * i, r = id >> 4, cc = id & 15; const v4u v = *(const v4u*)(KR + (size_t)(row0 + r) * 512 + h * 128 + cc * 8); *(LAS v4u*)(L + r * PK + cc * 16) = v; }
#pragma unroll
    for (int i = 0; i < 8; ++i) { const int id = tid + 512 * i, r = id >> 5, cc = id & 31; const v4u v = *(const v4u*)(PROJ + (size_t)(row0 + r) * NPROJ + 1792 + h * 256 + cc * 8); *(LAS v4u*)(L + VOFF + r * PV + cc * 16) = v; }
    __syncthreads();
    LAS const unsigned char* kb = L + (4 * g + q) * PK + (4 * p) * 2;
    LAS const unsigned char* vb = L + VOFF + (4 * g + q) * PV + (32 * w + 4 * p) * 2;
    const int u = cgi * 4 + h;
#pragma unroll 1
    for (int dir = 0; dir < 2; ++dir) {
        const float lg2 = dir ? lgb2 : lgf2;
        v4f acc[8][2];
#pragma unroll
        for (int a = 0; a < 8; ++a)
#pragma unroll
            for (int b = 0; b < 2; ++b) acc[a][b] = (v4f){0.f, 0.f, 0.f, 0.f};
#pragma unroll 1
        for (int ks = 0; ks < 4; ++ks) {
            h8 Bf[2];
#pragma unroll
            for (int et = 0; et < 2; ++et) {
                const s4 lo = tr_read(vb + ks * 32 * PV + et * 32), hi = tr_read(vb + ks * 32 * PV + 16 * PV + et * 32);
                float f[8];
#pragma unroll
                for (int r = 0; r < 4; ++r) { const int jl = 32 * ks + 4 * g + r, jh = jl + 16;
                    f[r] = bfs(lo[r]) * __builtin_amdgcn_exp2f(lg2 * (float)(dir ? jl : 127 - jl));
                    f[4 + r] = bfs(hi[r]) * __builtin_amdgcn_exp2f(lg2 * (float)(dir ? jh : 127 - jh)); }
                v4u pk; pk.x = pk2(f[0], f[1]); pk.y = pk2(f[2], f[3]); pk.z = pk2(f[4], f[5]); pk.w = pk2(f[6], f[7]);
                Bf[et] = __builtin_bit_cast(h8, pk);
            }
#pragma unroll
            for (int dt = 0; dt < 8; ++dt) {
                const s4 lo = tr_read(kb + ks * 32 * PK + dt * 32), hi = tr_read(kb + ks * 32 * PK + 16 * PK + dt * 32);
                const h8 Af = (h8){lo[0], lo[1], lo[2], lo[3], hi[0], hi[1], hi[2], hi[3]};
#pragma unroll
                for (int et = 0; et < 2; ++et) acc[dt][et] = __builtin_amdgcn_mfma_f32_16x16x32_bf16(Af, Bf[et], acc[dt][et], 0, 0, 0);
            }
        }
        bf16* so = ST + (size_t)(u * 2 + dir) * 32768;
#pragma unroll
        for (int dt = 0; dt < 8; ++dt)
#pragma unroll
            for (int et = 0; et < 2; ++et) { v2u o; o.x = pk2(acc[dt][et][0], acc[dt][et][1]); o.y = pk2(acc[dt][et][2], acc[dt][et][3]);
                *(v2u*)(so + (size_t)(32 * w + 16 * et + c) * 128 + 16 * dt + 4 * g) = o; }
    }
    __syncthreads();
}

__device__ __forceinline__ void ret_scan(unsigned* ST32, int nseq, int NC, const float* dec_f, const float* dec_b, int gtid, int gthreads) {
    const int total = nseq * 8 * 16384;
    for (int it = gtid; it < total; it += gthreads) {
        const int chain = it >> 14, off = it & 16383, seq = chain >> 3, h = (chain >> 1) & 3, dir = chain & 1;
        const float Gm = __builtin_amdgcn_exp2f(128.f * log2_gamma(dir ? dec_b[h] : dec_f[h]));
        float s0 = 0.f, s1 = 0.f;
        for (int n0 = 0; n0 < NC; n0 += 8) {
            unsigned v[8];
#pragma unroll
            for (int k = 0; k < 8; ++k) { const int n = dir ? NC - 1 - (n0 + k) : n0 + k; v[k] = ST32[((size_t)((seq * NC + n) * 4 + h) * 2 + dir) * 16384 + off]; }
#pragma unroll
            for (int k = 0; k < 8; ++k) { const int n = dir ? NC - 1 - (n0 + k) : n0 + k; const unsigned o = pk2(s0, s1);
                s0 = Gm * s0 + blo(v[k]); s1 = Gm * s1 + bhi(v[k]);
                ST32[((size_t)((seq * NC + n) * 4 + h) * 2 + dir) * 16384 + off] = o; }
        }
    }
}

__device__ __forceinline__ void ret_out_unit(LAS unsigned char* L, const bf16* QR, const bf16* KR, const bf16* PROJ, const bf16* ST, bf16* RET, const float* rnorm,
                                             int cgi, int h, float lgf2, float lgb2) {
    const int tid = ltid(), lane = tid & 63, w = tid >> 6, g = lane >> 4, c = lane & 15, q = c >> 2, p = lane & 3;
    const int row0 = cgi * 128;
    constexpr int PQ = 272, PV = 544, KOFF = 128 * PQ, VOFF = 2 * 128 * PQ, SOFF = VOFF + 128 * PV;
#pragma unroll
    for (int i = 0; i < 4; ++i) { const int id = tid + 512 * i, r = id >> 4, cc = id & 15;
        const v4u vq = *(const v4u*)(QR + (size_t)(row0 + r) * 512 + h * 128 + cc * 8); const v4u vk = *(const v4u*)(KR + (size_t)(row0 + r) * 512 + h * 128 + cc * 8);
        *(LAS v4u*)(L + r * PQ + cc * 16) = vq; *(LAS v4u*)(L + KOFF + r * PQ + cc * 16) = vk; }
#pragma unroll
    for (int i = 0; i < 8; ++i) { const int id = tid + 512 * i, r = id >> 5, cc = id & 31; const v4u v = *(const v4u*)(PROJ + (size_t)(row0 + r) * NPROJ + 1792 + h * 256 + cc * 8); *(LAS v4u*)(L + VOFF + r * PV + cc * 16) = v; }
    __syncthreads();
    {
        h8 Qf[4];
#pragma unroll
        for (int ks = 0; ks < 4; ++ks) Qf[ks] = *(LAS const h8*)(L + (16 * w + c) * PQ + (32 * ks + 8 * g) * 2);
        v4f sT[8];
#pragma unroll
        for (int jt = 0; jt < 8; ++jt) { v4f a = (v4f){0.f, 0.f, 0.f, 0.f};
#pragma unroll
            for (int ks = 0; ks < 4; ++ks) { const h8 Kf = *(LAS const h8*)(L + KOFF + (16 * jt + c) * PQ + (32 * ks + 8 * g) * 2); a = __builtin_amdgcn_mfma_f32_16x16x32_bf16(Kf, Qf[ks], a, 0, 0, 0); }
            const int i = 16 * w + c;
#pragma unroll
            for (int r = 0; r < 4; ++r) { const int j = 16 * jt + 4 * g + r, df = i - j; const float dec = __builtin_amdgcn_exp2f(df >= 0 ? lgf2 * (float)df : lgb2 * (float)(-df)); a[r] *= dec; }
            sT[jt] = a; }
        __syncthreads();
#pragma unroll
        for (int jt = 0; jt < 8; ++jt) { const int pos = 32 * (jt >> 1) + 8 * g + 4 * (jt & 1); v2u o; o.x = pk2(sT[jt][0], sT[jt][1]); o.y = pk2(sT[jt][2], sT[jt][3]);
            *(LAS v2u*)(L + KOFF + (16 * w + c) * PQ + pos * 2) = o; }
        __syncthreads();
    }
    v4f acc[2][8];
#pragma unroll
    for (int a = 0; a < 2; ++a)
#pragma unroll
        for (int b = 0; b < 8; ++b) acc[a][b] = (v4f){0.f, 0.f, 0.f, 0.f};
    const int u = cgi * 4 + h;
#pragma unroll 1
    for (int dir = 0; dir < 2; ++dir) {
        const bf16* S = ST + (size_t)(u * 2 + dir) * 32768 + (size_t)(32 * w + c) * 128 + 8 * g;
#pragma unroll 1
        for (int ks = 0; ks < 4; ++ks) {
            h8 Sf[2];
#pragma unroll
            for (int et = 0; et < 2; ++et) Sf[et] = *(const h8*)(S + et * 2048 + 32 * ks);
#pragma unroll
            for (int it = 0; it < 8; ++it) { const h8 Qf = *(LAS const h8*)(L + (16 * it + c) * PQ + (32 * ks + 8 * g) * 2);
#pragma unroll
                for (int et = 0; et < 2; ++et) acc[et][it] = __builtin_amdgcn_mfma_f32_16x16x32_bf16(Sf[et], Qf, acc[et][it], 0, 0, 0); }
        }
#pragma unroll
        for (int it = 0; it < 8; ++it) { const int i = 16 * it + c;
            const float sc = dir == 0 ? __builtin_amdgcn_exp2f(lgf2 * (float)(i + 1) - lgb2 * (float)(128 - i)) : __builtin_amdgcn_exp2f(lgb2 * (float)(128 - i));
#pragma unroll
            for (int et = 0; et < 2; ++et) acc[et][it] *= sc; }
    }
    {
        LAS const unsigned char* vb = L + VOFF + (4 * g + q) * PV + (32 * w + 4 * p) * 2;
#pragma unroll 1
        for (int ks = 0; ks < 4; ++ks) {
            h8 Vf[2];
#pragma unroll
            for (int et = 0; et < 2; ++et) { const s4 lo = tr_read(vb + ks * 32 * PV + et * 32), hi = tr_read(vb + ks * 32 * PV + 16 * PV + et * 32);
                Vf[et] = (h8){lo[0], lo[1], lo[2], lo[3], hi[0], hi[1], hi[2], hi[3]}; }
#pragma unroll
            for (int it = 0; it < 8; ++it) { const h8 Pf = *(LAS const h8*)(L + KOFF + (16 * it + c) * PQ + (32 * ks + 8 * g) * 2);
#pragma unroll
                for (int et = 0; et < 2; ++et) acc[et][it] = __builtin_amdgcn_mfma_f32_16x16x32_bf16(Vf[et], Pf, acc[et][it], 0, 0, 0); }
        }
    }
    LAS v2f* stats = (LAS v2f*)(L + SOFF);
#pragma unroll
    for (int it = 0; it < 8; ++it) { float s1 = 0.f, s2 = 0.f;
#pragma unroll
        for (int et = 0; et < 2; ++et)
#pragma unroll
            for (int r = 0; r < 4; ++r) { const float v = acc[et][it][r]; s1 += v; s2 += v * v; }
        s1 += __shfl_xor(s1, 16); s1 += __shfl_xor(s1, 32); s2 += __shfl_xor(s2, 16); s2 += __shfl_xor(s2, 32);
        if (g == 0) stats[(16 * it + c) * 8 + w] = (v2f){s1, s2}; __builtin_amdgcn_sched_barrier(0); }
    __syncthreads();
#pragma unroll
    for (int it = 0; it < 8; ++it) { const int i = 16 * it + c; float s1 = 0.f, s2 = 0.f;
#pragma unroll
        for (int k = 0; k < 8; ++k) { const v2f t = stats[i * 8 + k]; s1 += t.x; s2 += t.y; }
        const float mean = s1 * (1.f / 256.f), var = fmaxf(s2 * (1.f / 256.f) - mean * mean, 0.f), rstd = rsqrtf(var + 1e-6f);
#pragma unroll
        for (int et = 0; et < 2; ++et) { const int e = 32 * w + 16 * et + 4 * g;
            const v4f gn = *(const v4f*)(rnorm + h * 256 + e);
            const v2u gt = *(const v2u*)(PROJ + (size_t)(row0 + i) * NPROJ + 2816 + h * 256 + e);
            const v4f a = acc[et][it];
            v2u o; o.x = pk2((a[0] - mean) * rstd * gn[0] * blo(gt.x), (a[1] - mean) * rstd * gn[1] * bhi(gt.x));
            o.y = pk2((a[2] - mean) * rstd * gn[2] * blo(gt.y), (a[3] - mean) * rstd * gn[3] * bhi(gt.y));
            *(v2u*)(RET + (size_t)(row0 + i) * 1024 + h * 256 + e) = o; }
        asm volatile("" ::: "memory"); __builtin_amdgcn_sched_barrier(0); }
    __syncthreads();
}

struct Args { const float* in[17]; float* out; unsigned char* ws; };
typedef __attribute__((address_space(4))) const Args CArgs;
__device__ __forceinline__ CArgs* kargs() { CArgs* p = (CArgs*)__builtin_amdgcn_kernarg_segment_ptr(); asm volatile("" : "+s"(p)); return p; }
#define WSP(T, off) ((T*)(ws + (off)))
__global__ void __launch_bounds__(NTHR, 2) fwd_mega(Args a_unused) {
    extern __shared__ __attribute__((aligned(16))) unsigned char lds[];
    cg::grid_group grid = cg::this_grid();
    LAS unsigned char* L = (LAS unsigned char*)lds;
#define TIDS const int tid = ltid(), lane = tid & 63, wave = __builtin_amdgcn_readfirstlane(tid >> 6); const int G = lsgpr((int)gridDim.x), bx = lsgpr((int)blockIdx.x); \
    const int vcu = (G % 8 == 0) ? (bx % 8) * (G / 8) + bx / 8 : bx; const int gw = vcu * NWAVES + wave, NGW = G * NWAVES; (void)lane; (void)gw; (void)NGW; (void)vcu

    {
        CArgs* ap = kargs(); unsigned char* ws = ap->ws; TIDS;
        LAS float* scr = (LAS float*)(L + wave * 16384);
        constexpr int I_IN = (1024 / 64) * (NPROJ / 32), I_BA = (512 / 64) * (1024 / 32), I_BR = (1024 / 64) * (1024 / 32), I_OUT = I_BR, I_FI = (1024 / 64) * (2 * DFF / 32), I_FO = (DFF / 64) * (1024 / 32);
        constexpr int NITEMS = I_IN + I_BA + I_BR + I_OUT + I_FI + I_FO;
        for (int it = gw; it < NITEMS; it += NGW) {
            int r = it;
            if (r < I_IN) { transpose_item(ap->in[3], 1024, NPROJ, WSP(bf16, WS_WIN), scr, r, lane, nullptr, 0); continue; } r -= I_IN;
            if (r < I_BA) { transpose_item(ap->in[10], 512, 1024, WSP(bf16, WS_WBA), scr, r, lane, nullptr, 0); continue; } r -= I_BA;
            if (r < I_BR) { transpose_item(ap->in[11], 1024, 1024, WSP(bf16, WS_WBR), scr, r, lane, nullptr, 0); continue; } r -= I_BR;
            if (r < I_OUT) { transpose_item(ap->in[12], 1024, 1024, WSP(bf16, WS_WOUT), scr, r, lane, nullptr, 0); continue; } r -= I_OUT;
            if (r < I_FI) { transpose_item(ap->in[14], 1024, 2 * DFF, WSP(bf16, WS_WFI), scr, r, lane, ap->in[13], 1); continue; } r -= I_FI;
            transpose_item(ap->in[15], DFF, 1024, WSP(bf16, WS_WFO), scr, r, lane, nullptr, 0);
        }
        const float* x_prompt = ap->in[0]; const float* x_sample = ap->in[1]; const float* nmix = ap->in[2]; bf16* XN = WSP(bf16, WS_XN);
        for (int m = gw; m < NBATCH * MB; m += NGW) {
            const float* xr = (m < 2 * MB) ? x_prompt + (size_t)m * DMOD : x_sample + (size_t)(m - 2 * MB) * DMOD;
            rms_row_bf16(xr, nmix, XN + (size_t)m * DMOD, lane);
        }
        const int gt = bx * NTHR + tid;
        if (gt < 4096 + 8192) {
            const bool big = gt >= 4096; const int idx = big ? gt - 4096 : gt; const int nf = big ? 32 : 16; const int pos = idx / nf, f = idx % nf;
            const float inv = exp2f(-(float)f / (float)nf * 13.287712379549449f);
            float rev = (float)pos * inv * 0.15915494309189535f; rev -= floorf(rev);
            const v2f cs = (v2f){__builtin_amdgcn_cosf(rev), __builtin_amdgcn_sinf(rev)};
            if (big) WSP(v2f, WS_TAB128)[idx] = cs; else WSP(v2f, WS_TAB64)[idx] = cs;
        }
    }
    grid.sync();

#pragma unroll 1
    for (int b = 0; b < NBATCH; ++b) {
        if (b > 0) { CArgs* ap = kargs(); unsigned char* ws = ap->ws; TIDS; final_norm_rows(ap->out + (size_t)(b - 1) * MB * DMOD, WSP(float, WS_SS2), ap->in[16], gw, NGW, lane); }
        __syncthreads();
#ifndef SKIP_P1
        {
            CArgs* ap = kargs(); unsigned char* ws = ap->ws; TIDS;
            pg8::Gemm g{WSP(bf16, WS_XN) + (size_t)b * MB * DMOD, WSP(bf16, WS_WIN), MB, NPROJ, DMOD}; pg8::StaticOrder S; S.init(MB, NPROJ, G, bx);
            pg8::EpiProj E{WSP(bf16, WS_PROJ), ap->in[4]};
            pg8::gemm_phase<pg8::EpiProj, pg8::StaticOrder, true, true>(L, g, S, E);
        }
#endif
        grid.sync();
#ifndef SKIP_P1B
        { CArgs* ap = kargs(); unsigned char* ws = ap->ws; TIDS;
          prep_rows((b < 2) ? 2048 : 16384, WSP(bf16, WS_PROJ), WSP(bf16, WS_QA), WSP(bf16, WS_KA), WSP(bf16, WS_VA), WSP(bf16, WS_QR), WSP(bf16, WS_KR), ap->in[5], ap->in[6],
                    WSP(v2f, WS_TAB64), WSP(v2f, WS_TAB128), gw, NGW, lane); }
#endif
        grid.sync();
#ifndef SKIP_P2
        {
            { CArgs* ap = kargs(); unsigned char* ws = ap->ws; TIDS; const int per = (512 + G - 1) / G;
#ifndef SKIP_ATT
              for (int i = 0; i < per; ++i) { const int u = vcu * per + i; if (u >= 512) break;
                long rowbase; int hh, qb;
                if (b < 2) { rowbase = (long)(u >> 6) * 2048; hh = (u >> 3) & 7; qb = u & 7; } else { rowbase = 0; hh = u >> 6; qb = u & 63; }
                attn_body::attn_unit<8>(rowbase, (b < 2) ? 2048 : 16384, hh, qb, WSP(const attn_body::bf16, WS_QA), WSP(const attn_body::bf16, WS_KA), WSP(const attn_body::bf16, WS_VA), WSP(attn_body::bf16, WS_QA), (char*)lds);
              }
#endif
            }
            __syncthreads();
            { CArgs* ap = kargs(); unsigned char* ws = ap->ws; TIDS; const int per = (512 + G - 1) / G;
#ifndef SKIP_KV
              for (int i = 0; i < per; ++i) { const int u = vcu * per + i; if (u >= 512) break;
                const int hh = u & 3;
                ret_kv_unit(L, WSP(bf16, WS_KR), WSP(bf16, WS_PROJ), WSP(bf16, WS_ST), u >> 2, hh, log2_gamma(ap->in[7][hh]), log2_gamma(ap->in[8][hh]));
              }
#endif
            }
        }
#endif
        grid.sync();
#ifndef SKIP_P3
        { CArgs* ap = kargs(); unsigned char* ws = ap->ws; TIDS; const int T = (b < 2) ? 2048 : 16384;
          ret_scan(WSP(unsigned, WS_ST), MB / T, T / 128, ap->in[7], ap->in[8], bx * NTHR + tid, G * NTHR); }
#endif
        grid.sync();
#ifndef SKIP_P4
        {
            CArgs* ap = kargs(); unsigned char* ws = ap->ws; TIDS;
            const int per = (512 + G - 1) / G;
            for (int i = 0; i < per; ++i) { const int u = vcu * per + i; if (u >= 512) break;
                const int hh = u & 3;
                ret_out_unit(L, WSP(bf16, WS_QR), WSP(bf16, WS_KR), WSP(bf16, WS_PROJ), WSP(bf16, WS_ST), WSP(bf16, WS_RET), ap->in[9], u >> 2, hh, log2_gamma(ap->in[7][hh]), log2_gamma(ap->in[8][hh]));
            }
        }
#endif
        grid.sync();
#ifndef SKIP_P5
        {
            { CArgs* ap = kargs(); unsigned char* ws = ap->ws; TIDS; pg8::StaticOrder S; S.init(MB, 1024, G, bx);
              pg8::Gemm g{WSP(bf16, WS_QA), WSP(bf16, WS_WBA), MB, 1024, 512}; pg8::EpiBranch<false> E{WSP(bf16, WS_PROJ) + 3840, WSP(bf16, WS_MIX)};
              pg8::gemm_phase<pg8::EpiBranch<false>, pg8::StaticOrder, true, true>(L, g, S, E); }
            asm volatile("s_waitcnt vmcnt(0)" ::: "memory"); __syncthreads();
            { CArgs* ap = kargs(); unsigned char* ws = ap->ws; TIDS; pg8::StaticOrder S; S.init(MB, 1024, G, bx);
              pg8::Gemm g{WSP(bf16, WS_RET), WSP(bf16, WS_WBR), MB, 1024, 1024}; pg8::EpiBranch<true> E{WSP(bf16, WS_PROJ) + 4864, WSP(bf16, WS_MIX)};
              pg8::gemm_phase<pg8::EpiBranch<true>, pg8::StaticOrder, true, true>(L, g, S, E); }
        }
#endif
        grid.sync();
#ifndef SKIP_P6
        {
            CArgs* ap = kargs(); unsigned char* ws = ap->ws; TIDS;
            const float* xb = (b < 2) ? ap->in[0] + (size_t)b * MB * DMOD : ap->in[1];
            pg8::Gemm g{WSP(bf16, WS_MIX), WSP(bf16, WS_WOUT), MB, 1024, 1024}; pg8::StaticOrder S; S.init(MB, 1024, G, bx);
            pg8::EpiResid E{xb, ap->out + (size_t)b * MB * DMOD, WSP(bf16, WS_X1B), WSP(float, WS_SS1)};
            pg8::gemm_phase<pg8::EpiResid, pg8::StaticOrder, true, true>(L, g, S, E);
        }
#endif
        grid.sync();
#ifndef SKIP_P7
        {
            CArgs* ap = kargs(); unsigned char* ws = ap->ws; TIDS;
            pg8::Gemm g{WSP(bf16, WS_X1B), WSP(bf16, WS_WFI), MB, 2 * DFF, 1024}; pg8::StaticOrder S; S.init(MB, 2 * DFF, G, bx);
            pg8::EpiFfnIn E{WSP(float, WS_SS1), WSP(bf16, WS_PROJ)};
            pg8::gemm_phase<pg8::EpiFfnIn, pg8::StaticOrder, true, true>(L, g, S, E);
        }
#endif
        grid.sync();
#ifndef SKIP_P8
        {
            CArgs* ap = kargs(); unsigned char* ws = ap->ws; TIDS; float* outb = ap->out + (size_t)b * MB * DMOD;
            pg8::Gemm g{WSP(bf16, WS_PROJ), WSP(bf16, WS_WFO), MB, 1024, DFF}; pg8::StaticOrder S; S.init(MB, 1024, G, bx);
            pg8::EpiResid E{outb, outb, nullptr, WSP(float, WS_SS2)};
            pg8::gemm_phase<pg8::EpiResid, pg8::StaticOrder, true, true>(L, g, S, E);
        }
#endif
        grid.sync();
    }
    { CArgs* ap = kargs(); unsigned char* ws = ap->ws; TIDS; final_norm_rows(ap->out + (size_t)(NBATCH - 1) * MB * DMOD, WSP(float, WS_SS2), ap->in[16], gw, NGW, lane); }
}

extern "C" void kernel_launch(void* const* d_in, const int* in_sizes, int n_in, void* d_out, int out_size, void* d_ws, size_t ws_size, hipStream_t stream) {
    static int grid = 0;
    if (grid == 0) {
        if (n_in != 17 || ws_size < WS_END) { fprintf(stderr, "kernel_launch: unexpected n_in %d / ws_size %zu\n", n_in, ws_size); grid = -1; return; }
        int dev = 0, cus = 0, per_cu = 0;
        hipGetDevice(&dev); hipDeviceGetAttribute(&cus, hipDeviceAttributeMultiprocessorCount, dev);
        if (hipFuncSetAttribute((const void*)fwd_mega, hipFuncAttributeMaxDynamicSharedMemorySize, LDS_BYTES) != hipSuccess) fprintf(stderr, "kernel_launch: hipFuncSetAttribute failed\n");
        if (hipOccupancyMaxActiveBlocksPerMultiprocessor(&per_cu, (const void*)fwd_mega, NTHR, LDS_BYTES) != hipSuccess || per_cu < 1) { fprintf(stderr, "kernel_launch: occupancy query gave %d\n", per_cu); per_cu = 1; }
        (void)hipGetLastError();
        grid = cus * per_cu;
    }
    if (grid < 0) return;
    Args a{};
    for (int i = 0; i < 17; ++i) a.in[i] = (const float*)d_in[i];
    a.out = (float*)d_out; a.ws = (unsigned char*)d_ws;
    void* args[] = {&a};
    hipError_t e = hipLaunchCooperativeKernel((const void*)fwd_mega, dim3(grid), dim3(NTHR), args, LDS_BYTES, stream);
    if (e != hipSuccess) fprintf(stderr, "cooperative launch failed: %s (grid %d)\n", hipGetErrorString(e), grid);
}
```

```cpp
#include <hip/hip_runtime.h>
#include <hip/hip_cooperative_groups.h>
#include <hip/hip_bf16.h>
#include <cstdio>
#include <cstdint>
#include <cmath>
namespace cg = cooperative_groups;
__device__ __forceinline__ int ltid() { int t = (int)threadIdx.x; asm volatile("" : "+v"(t)); return t; }
__device__ __forceinline__ int lsgpr(int v) { asm volatile("" : "+s"(v)); return v; }
namespace pg8 {
#define PG8_LAS __attribute__((address_space(3)))
typedef unsigned short bf16_t;
typedef short bf16x8 __attribute__((ext_vector_type(8)));
typedef float f32x4 __attribute__((ext_vector_type(4)));
typedef unsigned u32x4 __attribute__((ext_vector_type(4)));
constexpr int BM = 256, BK = 64, HALF = 128, HTB = HALF * BK * 2  , STAGE_BYTES = 8 * HTB, NXCD = 8, WGM = 8;

__host__ __device__ __forceinline__ int lds_byte(int r, int c) { const int st = (r >> 4) * 2 + (c >> 5), rr = r & 15, cc = c & 31, ob = rr * 64 + cc * 2; return st * 1024 + (ob ^ (((ob >> 9) & 1) << 5)); }
__host__ __device__ __forceinline__ void stage_rc(int b, int& R, int& C) { const int st = b / 1024, sb = b % 1024, swz = sb ^ (((sb >> 9) & 1) << 5); R = (st >> 1) * 16 + swz / 64; C = (st & 1) * 32 + (swz % 64) / 2; }
__host__ __device__ __forceinline__ int perm32(int rho) { const int n = rho >> 4, i = rho & 15; return 8 * (i >> 2) + 4 * n + (i & 3); }

struct Unit { int pm, pn; };
struct Gemm { const bf16_t* A; const bf16_t* Bt; int M, N, K; };

struct StaticOrder {
    int nM, nN, nwg, G, c;
    __host__ __device__ void init(int M, int N, int G_, int c_) { nM = M / BM; nN = N / BM; nwg = nM * nN; G = G_; c = c_; }
    __host__ __device__ bool next(int i, Unit& u) const {
        const long L = (long)i * G + c; if (L >= nwg) return false;
        int wgid = (int)L; { const int q = nwg / NXCD, r = nwg % NXCD, xcd = wgid % NXCD, off = wgid / NXCD; wgid = (xcd < r ? xcd * (q + 1) : r * (q + 1) + (xcd - r) * q) + off; }
        const int nig = WGM * nN, gid = wgid / nig, fm = gid * WGM, gsz = (nM - fm) < WGM ? (nM - fm) : WGM;
        u.pm = fm + ((wgid % nig) % gsz); u.pn = (wgid % nig) / gsz; return true;
    }
    __device__ __forceinline__ void a_ready(const Unit&) const {}
    __device__ __forceinline__ void done(const Unit&) const {}
};

__device__ __forceinline__ unsigned cvt_pk_bf16(float lo, float hi) { unsigned r; asm volatile("v_cvt_pk_bf16_f32 %0, %1, %2" : "=v"(r) : "v"(lo), "v"(hi)); return r; }
typedef float f32x2 __attribute__((ext_vector_type(2)));
__device__ __forceinline__ float sigm(float z) { return __builtin_amdgcn_rcpf(1.0f + __expf(-z)); }
__device__ __forceinline__ float bflo(unsigned u) { return __uint_as_float(u << 16); }
__device__ __forceinline__ float bfhi(unsigned u) { return __uint_as_float(u & 0xffff0000u); }
#define EPI_FENCE() do { asm volatile("" ::: "memory"); __builtin_amdgcn_sched_barrier(0); } while (0)
struct EpiProj {
    static constexpr bool PERM = true, AFTER_DRAIN = false;
    bf16_t* O; const float* bgate;
    __device__ __forceinline__ void operator()(const f32x4 (&acc)[2][2][4][2], const Unit& u, int wr, int wc, int fr, int fq) const {
        const int row0 = u.pm * BM + wr * 64 + fr; const int col0 = u.pn * BM + wc * 32 + 8 * fq;
        const int mode = u.pn >= 15 ? 2 : (u.pn >= 11 ? 1 : 0);
        f32x4 bv[2][2];
#pragma unroll
        for (int bj = 0; bj < 2; ++bj)
#pragma unroll
            for (int n = 0; n < 2; ++n) bv[bj][n] = (mode == 2) ? *(const f32x4*)(bgate + (col0 - 3840) + bj * HALF + 4 * n) : (f32x4){0.f, 0.f, 0.f, 0.f};
        const unsigned off0 = ((unsigned)row0 * 5888u + (unsigned)col0) * 2u;
#pragma unroll
        for (int ai = 0; ai < 2; ++ai)
#pragma unroll
            for (int m = 0; m < 4; ++m) { char* rowp = (char*)O + (off0 + (unsigned)(ai * HALF + m * 16) * 11776u);
#pragma unroll
                for (int bj = 0; bj < 2; ++bj) { f32x4 v0 = acc[ai][bj][m][0] + bv[bj][0], v1 = acc[ai][bj][m][1] + bv[bj][1];
                    if (mode == 1) {
#pragma unroll
                        for (int e = 0; e < 4; ++e) { v0[e] = v0[e] * sigm(v0[e]); v1[e] = v1[e] * sigm(v1[e]); } }
                    else if (mode == 2) {
#pragma unroll
                        for (int e = 0; e < 4; ++e) { v0[e] = sigm(v0[e]); v1[e] = sigm(v1[e]); } }
                    u32x4 w; w.x = cvt_pk_bf16(v0[0], v0[1]); w.y = cvt_pk_bf16(v0[2], v0[3]); w.z = cvt_pk_bf16(v1[0], v1[1]); w.w = cvt_pk_bf16(v1[2], v1[3]);
                    *(u32x4*)(rowp + bj * HALF * 2) = w; }
                EPI_FENCE(); }
    }
};
template <bool ADD> struct EpiBranch {
    static constexpr bool PERM = true, AFTER_DRAIN = false;
    const bf16_t* G; bf16_t* O;
    __device__ __forceinline__ void operator()(const f32x4 (&acc)[2][2][4][2], const Unit& u, int wr, int wc, int fr, int fq) const {
        const int row0 = u.pm * BM + wr * 64 + fr; const int col0 = u.pn * BM + wc * 32 + 8 * fq;
        const unsigned goff0 = ((unsigned)row0 * 5888u + (unsigned)col0) * 2u, ooff0 = ((unsigned)row0 * 1024u + (unsigned)col0) * 2u;
#pragma unroll
        for (int ai = 0; ai < 2; ++ai)
#pragma unroll
            for (int m = 0; m < 4; ++m) { const unsigned rr = (unsigned)(ai * HALF + m * 16);
#pragma unroll
                for (int bj = 0; bj < 2; ++bj) {
                    const u32x4 g = *(const u32x4*)((const char*)G + (goff0 + rr * 11776u + bj * 256u));
                    f32x4 v0 = acc[ai][bj][m][0], v1 = acc[ai][bj][m][1];
                    v0[0] *= bflo(g.x); v0[1] *= bfhi(g.x); v0[2] *= bflo(g.y); v0[3] *= bfhi(g.y);
                    v1[0] *= bflo(g.z); v1[1] *= bfhi(g.z); v1[2] *= bflo(g.w); v1[3] *= bfhi(g.w);
                    char* op = (char*)O + (ooff0 + rr * 2048u + bj * 256u);
                    if (ADD) { const u32x4 p = *(const u32x4*)op;
                        v0[0] += bflo(p.x); v0[1] += bfhi(p.x); v0[2] += bflo(p.y); v0[3] += bfhi(p.y);
                        v1[0] += bflo(p.z); v1[1] += bfhi(p.z); v1[2] += bflo(p.w); v1[3] += bfhi(p.w); }
                    u32x4 w; w.x = cvt_pk_bf16(v0[0], v0[1]); w.y = cvt_pk_bf16(v0[2], v0[3]); w.z = cvt_pk_bf16(v1[0], v1[1]); w.w = cvt_pk_bf16(v1[2], v1[3]);
                    *(u32x4*)op = w; EPI_FENCE(); } }
    }
};
struct EpiResid {
    static constexpr bool PERM = true, AFTER_DRAIN = false;
    const float* base; float* out; bf16_t* ob; float* ss;
    __device__ __forceinline__ void operator()(const f32x4 (&acc)[2][2][4][2], const Unit& u, int wr, int wc, int fr, int fq) const {
        const int row0 = u.pm * BM + wr * 64 + fr; const int col0 = u.pn * BM + wc * 32 + 8 * fq;
        const unsigned off0 = ((unsigned)row0 * 1024u + (unsigned)col0) * 4u;
#pragma unroll
        for (int ai = 0; ai < 2; ++ai)
#pragma unroll
            for (int m = 0; m < 4; ++m) { const unsigned rr = (unsigned)(ai * HALF + m * 16); float s = 0.f;
#pragma unroll
                for (int bj = 0; bj < 2; ++bj) { const unsigned off = off0 + rr * 4096u + bj * 512u;
                    const f32x4 b0 = *(const f32x4*)((const char*)base + off), b1 = *(const f32x4*)((const char*)base + off + 16);
                    const f32x4 v0 = acc[ai][bj][m][0] + b0, v1 = acc[ai][bj][m][1] + b1;
                    *(f32x4*)((char*)out + off) = v0; *(f32x4*)((char*)out + off + 16) = v1;
                    s += (v0[0] * v0[0] + v0[1] * v0[1]) + (v0[2] * v0[2] + v0[3] * v0[3]) + (v1[0] * v1[0] + v1[1] * v1[1]) + (v1[2] * v1[2] + v1[3] * v1[3]);
                    if (ob) { u32x4 w; w.x = cvt_pk_bf16(v0[0], v0[1]); w.y = cvt_pk_bf16(v0[2], v0[3]); w.z = cvt_pk_bf16(v1[0], v1[1]); w.w = cvt_pk_bf16(v1[2], v1[3]); *(u32x4*)((char*)ob + (off >> 1)) = w; }
                    EPI_FENCE(); }
                s += __shfl_xor(s, 16); s += __shfl_xor(s, 32);
                if (fq == 0) ss[(unsigned)(row0 + rr) * 16u + u.pn * 4 + wc] = s; }
    }
};
struct EpiFfnIn {
    static constexpr bool PERM = true, AFTER_DRAIN = false;
    const float* ss; bf16_t* O;
    __device__ __forceinline__ void operator()(const f32x4 (&acc)[2][2][4][2], const Unit& u, int wr, int wc, int fr, int fq) const {
        const int row0 = u.pm * BM + wr * 64 + fr; const int col0 = u.pn * HALF + wc * 32 + 8 * fq;
        const unsigned off0 = ((unsigned)row0 * 2816u + (unsigned)col0) * 2u, soff0 = ((unsigned)row0 * 16u + 4u * fq) * 4u;
#pragma unroll
        for (int ai = 0; ai < 2; ++ai)
#pragma unroll
            for (int m = 0; m < 4; ++m) { const unsigned rr = (unsigned)(ai * HALF + m * 16);
                const f32x4 s0 = *(const f32x4*)((const char*)ss + (soff0 + rr * 64u));
                float tot = (s0[0] + s0[1]) + (s0[2] + s0[3]); tot += __shfl_xor(tot, 16); tot += __shfl_xor(tot, 32);
                const float r = rsqrtf(tot * (1.0f / 1024.0f) + 1e-6f);
                float o[8];
#pragma unroll
                for (int n = 0; n < 2; ++n)
#pragma unroll
                    for (int e = 0; e < 4; ++e) { const float gt = acc[ai][0][m][n][e] * r, up = acc[ai][1][m][n][e] * r; o[4 * n + e] = gt * sigm(gt) * up; }
                u32x4 w; w.x = cvt_pk_bf16(o[0], o[1]); w.y = cvt_pk_bf16(o[2], o[3]); w.z = cvt_pk_bf16(o[4], o[5]); w.w = cvt_pk_bf16(o[6], o[7]);
                *(u32x4*)((char*)O + (off0 + rr * 5632u)) = w; EPI_FENCE(); }
    }
};
template <class Epi, class Sched, bool ALIGN_EPI = false, bool SP2 = false>
__device__ __forceinline__ void gemm_phase(PG8_LAS unsigned char* lds, const Gemm g, const Sched& S, const Epi& E) {
    const int tid = ltid(), wid = __builtin_amdgcn_readfirstlane(tid >> 6), lane = tid & 63, wr = wid >> 2, wc = wid & 3, fr = lane & 15, fq = lane >> 4;
    const int K = g.K, nt = K / BK;
    unsigned voffA[2], voffB[2];
#pragma unroll
    for (int i = 0; i < 2; ++i) { int R, C; stage_rc(tid * 16 + i * 8192, R, C); const int Rb = Epi::PERM ? ((R & ~31) + perm32(R & 31)) : R;
        voffA[i] = (unsigned)(R * K + C) * 2u; voffB[i] = (unsigned)(Rb * K + C) * 2u; }
    const size_t kstep = (size_t)(BK * 2);
    const size_t hstep = (size_t)HALF * K * 2;
    const size_t tstep = 2 * hstep;
    const unsigned ldsw = (unsigned)wid * 1024u;
    const int aoff = lds_byte(wr * 64 + fr, fq * 8), boff = lds_byte(wc * 32 + fr, fq * 8);
#define PG8_SA(b, h) (((b) * 2 + (h)) * HTB)
#define PG8_SB(b, h) ((4 + (b) * 2 + (h)) * HTB)
#define PG8_STAGE(bufoff, gbase, voff) do { _Pragma("unroll") for (int _i = 0; _i < 2; ++_i) \
        __builtin_amdgcn_global_load_lds((const unsigned*)((const char*)(gbase) + (voff)[_i]), (PG8_LAS unsigned*)(lds + (bufoff) + ldsw + _i * 8192), 16, 0, 0); } while (0)
#define PG8_LDA(dst, b, h) do { _Pragma("unroll") for (int m = 0; m < 4; ++m) _Pragma("unroll") for (int k = 0; k < 2; ++k) dst[m][k] = *(const PG8_LAS bf16x8*)(lds + PG8_SA(b, h) + aoff + m * 2048 + k * 1024); } while (0)
#define PG8_LDB(dst, b, h) do { _Pragma("unroll") for (int n = 0; n < 2; ++n) _Pragma("unroll") for (int k = 0; k < 2; ++k) dst[n][k] = *(const PG8_LAS bf16x8*)(lds + PG8_SB(b, h) + boff + n * 2048 + k * 1024); } while (0)
#define PG8_MMA(ai, bj, At, Bt) do { __builtin_amdgcn_s_setprio(1); _Pragma("unroll") for (int m = 0; m < 4; ++m) _Pragma("unroll") for (int n = 0; n < 2; ++n) _Pragma("unroll") for (int k = 0; k < 2; ++k) \
        acc[ai][bj][m][n] = __builtin_amdgcn_mfma_f32_16x16x32_bf16(Bt[n][k], At[m][k], acc[ai][bj][m][n], 0, 0, 0); __builtin_amdgcn_s_setprio(0); } while (0)
#define PG8_WAIT_V(n) asm volatile("s_waitcnt vmcnt(" #n ")" ::: "memory")
#define PG8_WAIT_L(n) asm volatile("s_waitcnt lgkmcnt(" #n ")" ::: "memory")
#define PG8_BAR __builtin_amdgcn_s_barrier()
#define PG8_SCHED __builtin_amdgcn_sched_barrier(0)
    Unit cur, nxt; int ui = 0;
    if (!S.next(0, cur)) return;
    f32x4 acc[2][2][4][2];
#pragma unroll
    for (int a = 0; a < 2; ++a)
#pragma unroll
        for (int b = 0; b < 2; ++b)
#pragma unroll
            for (int m = 0; m < 4; ++m)
#pragma unroll
                for (int n = 0; n < 2; ++n) acc[a][b][m][n] = (f32x4){0.f, 0.f, 0.f, 0.f};
    bf16x8 At[4][2], B0[2][2], B1[2][2];
    const char* cA = (const char*)g.A + (size_t)cur.pm * tstep; const char* cB = (const char*)g.Bt + (size_t)cur.pn * tstep;
    S.a_ready(cur);
    if constexpr (SP2) {
        PG8_STAGE(PG8_SB(0, 0), cB, voffB); PG8_STAGE(PG8_SB(0, 1), cB + hstep, voffB); PG8_STAGE(PG8_SA(0, 0), cA, voffA); PG8_STAGE(PG8_SA(0, 1), cA + hstep, voffA);
        if (wr == 1) PG8_BAR;
        PG8_WAIT_V(2); PG8_BAR;
        PG8_STAGE(PG8_SB(1, 0), cB + kstep, voffB); PG8_STAGE(PG8_SA(1, 0), cA + kstep, voffA); PG8_STAGE(PG8_SB(1, 1), cB + hstep + kstep, voffB);
        PG8_WAIT_V(6); PG8_BAR;
    } else {
        PG8_STAGE(PG8_SB(0, 0), cB, voffB); PG8_STAGE(PG8_SA(0, 0), cA, voffA); PG8_STAGE(PG8_SB(0, 1), cB + hstep, voffB); PG8_STAGE(PG8_SA(0, 1), cA + hstep, voffA);
        if (wr == 1) PG8_BAR;
        PG8_WAIT_V(4); PG8_BAR;
        PG8_STAGE(PG8_SB(1, 0), cB + kstep, voffB); PG8_STAGE(PG8_SA(1, 0), cA + kstep, voffA); PG8_STAGE(PG8_SB(1, 1), cB + hstep + kstep, voffB);
        PG8_WAIT_V(6); PG8_BAR;
    }
    for (;;) {
        const bool has_next = S.next(ui + 1, nxt);
        const char* nA = has_next ? (const char*)g.A + (size_t)nxt.pm * tstep : cA; const char* nB = has_next ? (const char*)g.Bt + (size_t)nxt.pn * tstep : cB;
        for (int t = 0; t < nt; t += 2) {
            const bool last = (t == nt - 2);
            const char* a1 = cA + (size_t)(t + 1) * kstep;
            const char* a2 = last ? nA : cA + (size_t)(t + 2) * kstep; const char* b2 = last ? nB : cB + (size_t)(t + 2) * kstep;
            const char* a3 = a2 + kstep; const char* b3 = b2 + kstep;
            if (last && has_next) S.a_ready(nxt);
            if constexpr (SP2) {
            PG8_LDB(B0, 0, 0); PG8_LDB(B1, 0, 1); PG8_SCHED; PG8_LDA(At, 0, 0); PG8_STAGE(PG8_SA(1, 1), a1 + hstep, voffA);
            PG8_WAIT_V(8); PG8_WAIT_L(0); PG8_BAR; PG8_MMA(0, 0, At, B0); PG8_MMA(0, 1, At, B1); PG8_BAR; PG8_SCHED;
            PG8_LDA(At, 0, 1); PG8_STAGE(PG8_SB(0, 0), b2, voffB); PG8_STAGE(PG8_SB(0, 1), b2 + hstep, voffB); PG8_STAGE(PG8_SA(0, 0), a2, voffA);
            PG8_WAIT_V(8); PG8_WAIT_L(0); PG8_BAR; PG8_MMA(1, 0, At, B0); PG8_MMA(1, 1, At, B1); PG8_BAR; PG8_SCHED;
            PG8_LDB(B0, 1, 0); PG8_LDB(B1, 1, 1); PG8_SCHED; PG8_LDA(At, 1, 0); PG8_STAGE(PG8_SA(0, 1), a2 + hstep, voffA);
            PG8_WAIT_V(8); PG8_WAIT_L(0); PG8_BAR; PG8_MMA(0, 0, At, B0); PG8_MMA(0, 1, At, B1); PG8_BAR; PG8_SCHED;
            PG8_LDA(At, 1, 1); PG8_STAGE(PG8_SB(1, 0), b3, voffB); PG8_STAGE(PG8_SB(1, 1), b3 + hstep, voffB); PG8_STAGE(PG8_SA(1, 0), a3, voffA);
            PG8_WAIT_V(8); PG8_WAIT_L(0); PG8_BAR; PG8_MMA(1, 0, At, B0); PG8_MMA(1, 1, At, B1); PG8_BAR; PG8_SCHED;
            } else {
            PG8_LDB(B0, 0, 0); PG8_SCHED; PG8_LDA(At, 0, 0); PG8_STAGE(PG8_SA(1, 1), a1 + hstep, voffA);
            PG8_WAIT_L(8); PG8_BAR; PG8_WAIT_L(0); PG8_MMA(0, 0, At, B0); PG8_BAR; PG8_SCHED;
            PG8_LDB(B1, 0, 1); PG8_STAGE(PG8_SB(0, 0), b2, voffB);
            PG8_BAR; PG8_WAIT_L(0); PG8_MMA(0, 1, At, B1); PG8_BAR;
            PG8_LDA(At, 0, 1); PG8_STAGE(PG8_SA(0, 0), a2, voffA);
            PG8_BAR; PG8_WAIT_L(0); PG8_MMA(1, 0, At, B0); PG8_BAR; PG8_SCHED;
            PG8_STAGE(PG8_SB(0, 1), b2 + hstep, voffB);
            PG8_WAIT_V(6); PG8_BAR; PG8_MMA(1, 1, At, B1); PG8_BAR;
            PG8_LDB(B0, 1, 0); PG8_SCHED; PG8_LDA(At, 1, 0); PG8_STAGE(PG8_SA(0, 1), a2 + hstep, voffA);
            PG8_WAIT_L(8); PG8_BAR; PG8_WAIT_L(0); PG8_MMA(0, 0, At, B0); PG8_BAR; PG8_SCHED;
            PG8_LDB(B1, 1, 1); PG8_STAGE(PG8_SB(1, 0), b3, voffB);
            PG8_BAR; PG8_WAIT_L(0); PG8_MMA(0, 1, At, B1); PG8_BAR;
            PG8_LDA(At, 1, 1); PG8_STAGE(PG8_SA(1, 0), a3, voffA);
            PG8_BAR; PG8_WAIT_L(0); PG8_MMA(1, 0, At, B0); PG8_BAR; PG8_SCHED;
            PG8_STAGE(PG8_SB(1, 1), b3 + hstep, voffB);
            PG8_WAIT_V(6); PG8_BAR; PG8_MMA(1, 1, At, B1); PG8_BAR;
            }
        }
        if constexpr (ALIGN_EPI) { if (wr == 0) PG8_BAR; }
        if constexpr (!Epi::AFTER_DRAIN) { E(acc, cur, wr, wc, fr, fq); S.done(cur); }
        if (!has_next) break;
#pragma unroll
        for (int a = 0; a < 2; ++a)
#pragma unroll
            for (int b = 0; b < 2; ++b)
#pragma unroll
                for (int m = 0; m < 4; ++m)
#pragma unroll
                    for (int n = 0; n < 2; ++n) acc[a][b][m][n] = (f32x4){0.f, 0.f, 0.f, 0.f};
        cur = nxt; cA = nA; cB = nB; ++ui;
        if constexpr (ALIGN_EPI) { if (wr == 1) PG8_BAR; }
    }
    PG8_WAIT_V(0);
    if constexpr (!ALIGN_EPI) { if (wr == 0) PG8_BAR; }
    PG8_BAR;
    if constexpr (Epi::AFTER_DRAIN) { E.fused(acc, cur, wr, wc, fr, fq, lds, wid, lane); S.done(cur); }
#undef PG8_SA
#undef PG8_SB
#undef PG8_STAGE
#undef PG8_LDA
#undef PG8_LDB
#undef PG8_MMA
#undef PG8_WAIT_V
#undef PG8_WAIT_L
#undef PG8_BAR
#undef PG8_SCHED
}
}
namespace attn_body {
using bf16=__hip_bfloat16;
using bf16x8=__attribute__((ext_vector_type(8)))short;
using s16x4=__attribute__((ext_vector_type(4)))short;
using f32x16=__attribute__((ext_vector_type(16)))float;
using u32x4=__attribute__((ext_vector_type(4)))unsigned;
constexpr int D=64,QP=512,KP=128;
constexpr int NW=8,QBLK=32,QB=QBLK*NW,KVBLK=64;

__device__ __forceinline__ int crow(int r,int hi){return (r&3)+8*(r>>2)+4*hi;}
#define SBAR() __builtin_amdgcn_sched_barrier(0)
__device__ __forceinline__ void cmask(f32x16&p0,f32x16&p1,int jb,int qrel,int hi){
  const float NEG=-INFINITY; int kb=64*jb+4*hi;
  #pragma unroll
  for(int r=0;r<16;++r){int kv=kb+(r&3)+8*(r>>2); if(kv>qrel)p0[r]=NEG; if(kv+32>qrel)p1[r]=NEG;}
}

constexpr int NSLOT=3, SLOTB=8192;
constexpr int LDS_K=0, LDS_V=NSLOT*SLOTB, LDS_WS=2*NSLOT*SLOTB, LDS_OST=LDS_WS+NW*64*4, LDS_BYTES=LDS_OST+NW*4096;
constexpr float C2=0.125f*1.4426950408889634f;
__device__ __forceinline__ void glds16(const void*gsrc,unsigned lds_dst){unsigned keep;
  asm volatile("s_mov_b32 %0, m0\n\ts_mov_b32 m0, %2\n\ts_nop 0\n\tglobal_load_lds_dwordx4 %1, off\n\ts_mov_b32 m0, %0":"=&s"(keep):"v"(gsrc),"s"(lds_dst):"memory");}
__device__ __forceinline__ float max3f(float a,float b,float c){float r;asm("v_max3_f32 %0, %1, %2, %3":"=v"(r):"v"(a),"v"(b),"v"(c));return r;}
__device__ __forceinline__ float max2f(float a,float b){float r;asm("v_max_f32_e32 %0, %1, %2":"=v"(r):"v"(a),"v"(b));return r;}
__device__ __forceinline__ float fadd_s(float a,float b){float r;asm("v_add_f32_e32 %0, %1, %2":"=v"(r):"v"(a),"v"(b));return r;}
__device__ __forceinline__ float fsub_s(float a,float b){float r;asm("v_sub_f32_e32 %0, %1, %2":"=v"(r):"v"(a),"v"(b));return r;}
typedef float f32x2_t __attribute__((ext_vector_type(2))); typedef __bf16 bf16x2_t __attribute__((ext_vector_type(2)));
__device__ __forceinline__ unsigned cvtpk_s(float lo,float hi){f32x2_t v={lo,hi};bf16x2_t b=__builtin_convertvector(v,bf16x2_t);return __builtin_bit_cast(unsigned,b);}
#define WAIT_BAR(N) asm volatile("s_waitcnt vmcnt(" #N ") lgkmcnt(0)\n\ts_barrier":::"memory")

__device__ __forceinline__ void qkt(f32x16&p0,f32x16&p1,const char*Kslot,const bf16x8*qr,const f32x16&negm,int r32,int hi){
  const char*kb=Kslot+hi*1024+r32*16;
  #pragma unroll
  for(int d0=0;d0<4;++d0){
    const bf16x8 b0=*reinterpret_cast<const bf16x8*>(kb+d0*2048);
    const bf16x8 b1=*reinterpret_cast<const bf16x8*>(kb+d0*2048+512);
    if(d0==0){p0=__builtin_amdgcn_mfma_f32_32x32x16_bf16(b0,qr[0],negm,0,0,0);p1=__builtin_amdgcn_mfma_f32_32x32x16_bf16(b1,qr[0],negm,0,0,0);}
    else{p0=__builtin_amdgcn_mfma_f32_32x32x16_bf16(b0,qr[d0],p0,0,0,0);p1=__builtin_amdgcn_mfma_f32_32x32x16_bf16(b1,qr[d0],p1,0,0,0);}}
}
typedef __attribute__((address_space(3))) const char* lds_cptr;
typedef short v4i16_t __attribute__((ext_vector_type(4)));
__device__ __forceinline__ void kload8(bf16x8*kf,lds_cptr kp){
  kf[0]=*(const __attribute__((address_space(3))) bf16x8*)(kp);      kf[1]=*(const __attribute__((address_space(3))) bf16x8*)(kp+512);
  kf[2]=*(const __attribute__((address_space(3))) bf16x8*)(kp+2048); kf[3]=*(const __attribute__((address_space(3))) bf16x8*)(kp+2560);
  kf[4]=*(const __attribute__((address_space(3))) bf16x8*)(kp+4096); kf[5]=*(const __attribute__((address_space(3))) bf16x8*)(kp+4608);
  kf[6]=*(const __attribute__((address_space(3))) bf16x8*)(kp+6144); kf[7]=*(const __attribute__((address_space(3))) bf16x8*)(kp+6656);
}
__device__ __forceinline__ void kload2(bf16x8*kf,lds_cptr kp,int j){ kf[2*j]=*(const __attribute__((address_space(3))) bf16x8*)(kp+j*2048); kf[2*j+1]=*(const __attribute__((address_space(3))) bf16x8*)(kp+j*2048+512); }
__device__ __forceinline__ s16x4 vtr(lds_cptr p){ return __builtin_bit_cast(s16x4,__builtin_amdgcn_ds_read_tr16_b64_v4i16((__attribute__((address_space(3))) v4i16_t*)p)); }
__device__ __forceinline__ float rowmax(const f32x16&p0,const f32x16&p1){
  float a=max3f(p0[0],p0[1],p1[0]),b=max3f(p0[2],p0[3],p1[1]);a=max3f(a,p1[2],p1[3]);
  #pragma unroll
  for(int r=4;r<16;r+=4){a=max3f(a,p0[r],p0[r+1]);b=max3f(b,p0[r+2],p0[r+3]);a=max3f(a,p1[r],p1[r+1]);b=max3f(b,p1[r+2],p1[r+3]);}
  const float m=max2f(a,b);
  auto rr=__builtin_amdgcn_permlane32_swap(__float_as_uint(m),__float_as_uint(m),false,false);
  return max2f(__uint_as_float(rr[0]),__uint_as_float(rr[1]));
}
__device__ __forceinline__ void pv(f32x16*o,int vb,bf16x8 pa0,bf16x8 pa1,bf16x8 pa2,bf16x8 pa3){
  #pragma unroll
  for(int d0=0;d0<2;++d0){s16x4 lo[4],hi[4];
    #pragma unroll
    for(int ks=0;ks<4;++ks){
      asm volatile("ds_read_b64_tr_b16 %0,%1 offset:%c2":"=&v"(lo[ks]):"v"(vb),"i"(d0*4096+ks*1024):"memory");
      asm volatile("ds_read_b64_tr_b16 %0,%1 offset:%c2":"=&v"(hi[ks]):"v"(vb),"i"(d0*4096+ks*1024+512):"memory");}
    asm volatile("s_waitcnt lgkmcnt(0)":::"memory");SBAR();
    #define PK(k) (bf16x8){lo[k][0],lo[k][1],lo[k][2],lo[k][3],hi[k][0],hi[k][1],hi[k][2],hi[k][3]}
    o[d0]=__builtin_amdgcn_mfma_f32_32x32x16_bf16(pa0,PK(0),o[d0],0,0,0);
    o[d0]=__builtin_amdgcn_mfma_f32_32x32x16_bf16(pa1,PK(1),o[d0],0,0,0);
    o[d0]=__builtin_amdgcn_mfma_f32_32x32x16_bf16(pa2,PK(2),o[d0],0,0,0);
    o[d0]=__builtin_amdgcn_mfma_f32_32x32x16_bf16(pa3,PK(3),o[d0],0,0,0);
    #undef PK
  }
}

#ifndef ATTN_STORE16
#define ATTN_STORE16(p,v) (*(u32x4*)(p)=(v))
#endif
template<int THRL> __device__ __forceinline__ void attn_unit(long rowbase,int T,int h,int qb,const bf16*Q,const bf16*__restrict__ K,const bf16*__restrict__ V,bf16*O,char*shm){
  const int tid=ltid(),lane=tid&63,r32=lane&31,hi=lane>>5; const int wid=__builtin_amdgcn_readfirstlane(tid>>6);
  const int q0=qb*QB;
  const bf16*Qw=Q+(rowbase+q0+wid*QBLK)*QP+h*D;
  const bf16*Kh=K+rowbase*KP+(h>>2)*D,*Vh=V+rowbase*KP+(h>>2)*D;
  const unsigned lds0=(unsigned)(uintptr_t)shm;
  float*wsf=(float*)(shm+LDS_WS)+wid*64;
  const bf16*ksrc=Kh+(long)lane*KP+wid*8;
  const bf16*vsrc=Vh+(long)(16*(wid&3)+(lane>>2))*KP+(wid>>2)*32+(lane&3)*8;
  const unsigned kdst=lds0+LDS_K+wid*1024, vdst=lds0+LDS_V+wid*1024;
  #define DMA_K(t,slot) glds16(ksrc+(long)(t)*KVBLK*KP,(unsigned)__builtin_amdgcn_readfirstlane(kdst+(slot)))
  #define DMA_V(t,slot) glds16(vsrc+(long)(t)*KVBLK*KP,(unsigned)__builtin_amdgcn_readfirstlane(vdst+(slot)))
  const int vb0=(int)(lds0+LDS_V)+((lane>>4)&1)*32+(lane&3)*8+(4*hi+((lane&15)>>2))*64;
  const char*Kbase=shm+LDS_K; bf16x8 kf[8];
  const lds_cptr shm3=(lds_cptr)shm; const lds_cptr kp0=shm3+LDS_K+hi*1024+r32*16; const lds_cptr vp0=shm3+LDS_V+((lane>>4)&1)*32+(lane&3)*8+(4*hi+((lane&15)>>2))*64;
  const int NT=T/KVBLK;
  DMA_K(0,0);DMA_V(0,0);DMA_K(1,SLOTB);
  bf16x8 qr[4];
  #pragma unroll
  for(int d0=0;d0<4;++d0)qr[d0]=*reinterpret_cast<const bf16x8*>(&Qw[(long)r32*QP+d0*16+hi*8]);
  float mhat=0.f,l_reg=0.f;f32x16 o[2];o[0]=f32x16{};o[1]=f32x16{};f32x16 negm=f32x16{};asm volatile("":"+v"(negm));
  const int qrel=wid*QBLK+r32;
  #define CMASK(P0,P1,t) do{}while(0)
  bool resc=false;
  #define START(P0,P1) do{ const float rm=rowmax(P0,P1); resc=false; \
    { const float dl=rm; mhat=fadd_s(mhat,dl); \
      _Pragma("unroll") for(int r=0;r<16;++r){P0[r]=fsub_s(P0[r],dl);P1[r]=fsub_s(P1[r],dl);} \
      _Pragma("unroll") for(int r=0;r<16;++r)negm[r]=-mhat; asm volatile("":"+v"(negm)); } \
    _Pragma("unroll") for(int r=0;r<16;++r)P0[r]=__builtin_amdgcn_exp2f(P0[r]); }while(0)
  #define RESC() do{ if(resc){ asm volatile("s_waitcnt lgkmcnt(0)":::"memory"); \
      _Pragma("unroll") for(int d_=0;d_<2;++d_) _Pragma("unroll") for(int r=0;r<16;++r)o[d_][r]*=wsf[crow(r,hi)]; } }while(0)
  f32x16 pA0,pA1,pB0,pB1;
  int sl_prev=0,sl_cur=0,sl_next=SLOTB;
  #define ROT() do{sl_prev=sl_cur;sl_cur=sl_next;sl_next=(sl_next==(NSLOT-1)*SLOTB)?0:sl_next+SLOTB;}while(0)
  DMA_K(2,2*SLOTB);
  WAIT_BAR(3);
  qkt(pA0,pA1,Kbase,qr,negm,r32,hi);asm volatile("s_nop 15\n\ts_nop 7":"+v"(pA0),"+v"(pA1));CMASK(pA0,pA1,0);
  START(pA0,pA1);
  _Pragma("unroll") for(int r=0;r<16;++r)pA1[r]=__builtin_amdgcn_exp2f(pA1[r]);
  WAIT_BAR(0);
  DMA_K(3,0);DMA_V(1,SLOTB);
  ROT();
  kload8(kf,kp0+sl_cur);
  WAIT_BAR(2);
  s16x4 vlo[8],vhi[8]; u32x4 pw0,pw1,pw2,pw3;
  #define PKW(P,B) cvtpk_s(P[B],P[B+1])
  #define PAF(k) __builtin_bit_cast(bf16x8,pw##k)
  #define VFR(i) (bf16x8){vlo[i][0],vlo[i][1],vlo[i][2],vlo[i][3],vhi[i][0],vhi[i][1],vhi[i][2],vhi[i][3]}
  #define PIN(x) asm volatile("":"+v"(x))
  #define MX3(a,b,c) __builtin_fmaxf(__builtin_fmaxf((a),(b)),(c))
  #define GAPA(MF,A0,A1,A2,A3,W0,W1,PW) do{ MF; sacc+=A0; sacc+=A1; sacc+=A2; sacc+=A3; PIN(sacc); W0; W1; PIN(PW); SBAR(); }while(0)
  #define EX(v) __builtin_amdgcn_exp2f(v)
  #define GAPB(MF,X,B) do{ MF; X[B]=EX(X[B]); X[B+1]=EX(X[B+1]); X[B+2]=EX(X[B+2]); X[B+3]=EX(X[B+3]); PIN(X); SBAR(); }while(0)
  #define VRD(i) do{ vlo[i]=vtr(vp_+(((i)>>2)*4096+((i)&3)*1024)); vhi[i]=vtr(vp_+(((i)>>2)*4096+((i)&3)*1024+512)); }while(0)
  #define KRD(G,j) do{ if(G){ kload2(kf,kp0+sl_next,j); SBAR(); } }while(0)
  #define STEP(C0,C1,P0,P1,t,GK,GV,GL) do{ SBAR(); \
    const lds_cptr vp_=vp0+sl_prev; \
    VRD(0); SBAR(); float sacc=(P0[0]+P0[1]); \
    GAPA(C0=__builtin_amdgcn_mfma_f32_32x32x16_bf16(kf[0],qr[0],negm,0,0,0), P0[2],P0[3],P0[4],P0[5],     pw0[0]=PKW(P0,0), pw0[1]=PKW(P0,2), pw0); \
    VRD(4); SBAR(); GAPA(C1=__builtin_amdgcn_mfma_f32_32x32x16_bf16(kf[1],qr[0],negm,0,0,0), P0[6],P0[7],P0[8],P0[9],     pw0[2]=PKW(P0,4), pw0[3]=PKW(P0,6), pw0); \
    VRD(1); SBAR(); GAPA(C0=__builtin_amdgcn_mfma_f32_32x32x16_bf16(kf[2],qr[1],C0,0,0,0),   P0[10],P0[11],P0[12],P0[13], pw1[0]=PKW(P0,8), pw1[1]=PKW(P0,10), pw1); \
    VRD(5); SBAR(); GAPA(C1=__builtin_amdgcn_mfma_f32_32x32x16_bf16(kf[3],qr[1],C1,0,0,0),   P0[14],P0[15],P1[0],P1[1],   pw1[2]=PKW(P0,12),pw1[3]=PKW(P0,14), pw1); \
    VRD(2); SBAR(); GAPA(C0=__builtin_amdgcn_mfma_f32_32x32x16_bf16(kf[4],qr[2],C0,0,0,0),   P1[2],P1[3],P1[4],P1[5],     pw2[0]=PKW(P1,0), pw2[1]=PKW(P1,2), pw2); \
    VRD(6); SBAR(); GAPA(C1=__builtin_amdgcn_mfma_f32_32x32x16_bf16(kf[5],qr[2],C1,0,0,0),   P1[6],P1[7],P1[8],P1[9],     pw2[2]=PKW(P1,4), pw2[3]=PKW(P1,6), pw2); \
    VRD(3); SBAR(); GAPA(C0=__builtin_amdgcn_mfma_f32_32x32x16_bf16(kf[6],qr[3],C0,0,0,0),   P1[10],P1[11],P1[12],P1[13], pw3[0]=PKW(P1,8), pw3[1]=PKW(P1,10), pw3); \
    VRD(7); SBAR(); GAPA(C1=__builtin_amdgcn_mfma_f32_32x32x16_bf16(kf[7],qr[3],C1,0,0,0),   P1[14],P1[15],0.f,0.f,       pw3[2]=PKW(P1,12),pw3[3]=PKW(P1,14), pw3); \
    l_reg+=sacc; \
    if(GK){DMA_K((t)+3,sl_cur);} if(GV){DMA_V((t)+1,sl_next);} \
    CMASK(C0,C1,t); \
    { float a=MX3(C0[0],C0[1],C1[0]),b=MX3(C0[2],C0[3],C1[1]); a=MX3(a,C1[2],C1[3]); \
      _Pragma("unroll") for(int r=4;r<16;r+=4){a=MX3(a,C0[r],C0[r+1]);b=MX3(b,C0[r+2],C0[r+3]);a=MX3(a,C1[r],C1[r+1]);b=MX3(b,C1[r+2],C1[r+3]);} \
      float rm=__builtin_fmaxf(a,b); { auto rr=__builtin_amdgcn_permlane32_swap(__float_as_uint(rm),__float_as_uint(rm),false,false); rm=__builtin_fmaxf(__uint_as_float(rr[0]),__uint_as_float(rr[1])); } \
      resc=false; \
      if(__builtin_expect(__any(rm>(float)THRL),0)){ const float dl=__builtin_fmaxf(rm,0.f); mhat+=dl; \
        _Pragma("unroll") for(int r=0;r<16;++r){C0[r]-=dl;C1[r]-=dl;} \
        _Pragma("unroll") for(int r=0;r<16;++r)negm[r]=-mhat; asm volatile("":"+v"(negm)); \
        const float f=__builtin_amdgcn_exp2f(-dl); l_reg*=f; if(hi==0)wsf[r32]=f; resc=true; } } \
    SBAR(); \
    GAPB(o[0]=__builtin_amdgcn_mfma_f32_32x32x16_bf16(PAF(0),VFR(0),o[0],0,0,0), C0,0); \
    GAPB(o[1]=__builtin_amdgcn_mfma_f32_32x32x16_bf16(PAF(0),VFR(4),o[1],0,0,0), C0,4); \
    KRD(GL,0); GAPB(o[0]=__builtin_amdgcn_mfma_f32_32x32x16_bf16(PAF(1),VFR(1),o[0],0,0,0), C0,8); \
    KRD(GL,1); GAPB(o[1]=__builtin_amdgcn_mfma_f32_32x32x16_bf16(PAF(1),VFR(5),o[1],0,0,0), C0,12); \
    KRD(GL,2); GAPB(o[0]=__builtin_amdgcn_mfma_f32_32x32x16_bf16(PAF(2),VFR(2),o[0],0,0,0), C1,0); \
    KRD(GL,3); GAPB(o[1]=__builtin_amdgcn_mfma_f32_32x32x16_bf16(PAF(2),VFR(6),o[1],0,0,0), C1,4); \
    GAPB(o[0]=__builtin_amdgcn_mfma_f32_32x32x16_bf16(PAF(3),VFR(3),o[0],0,0,0), C1,8); \
    GAPB(o[1]=__builtin_amdgcn_mfma_f32_32x32x16_bf16(PAF(3),VFR(7),o[1],0,0,0), C1,12); \
    }while(0)
  int t=1;
  #undef CMASK
  #define CMASK(P0,P1,t) do{}while(0)
  for(;t+5<NT;t+=2){
    STEP(pB0,pB1,pA0,pA1,t,true,true,true);     WAIT_BAR(2); RESC(); ROT();
    STEP(pA0,pA1,pB0,pB1,t+1,true,true,true);   WAIT_BAR(2); RESC(); ROT();
  }
  #undef CMASK
  #define CMASK(P0,P1,t) do{}while(0)
  #define ENDW(tt) do{ if((tt)+3<NT){WAIT_BAR(2);} else if((tt)+2<NT){WAIT_BAR(1);} else {WAIT_BAR(0);} }while(0)
  for(;t+1<NT;t+=2){
    STEP(pB0,pB1,pA0,pA1,t,(t+3<NT),(t+1<NT),(t+1<NT));       ENDW(t);   RESC(); ROT();
    STEP(pA0,pA1,pB0,pB1,t+1,(t+4<NT),(t+2<NT),(t+2<NT));     ENDW(t+1); RESC(); ROT();
  }
  STEP(pB0,pB1,pA0,pA1,NT-1,false,false,false); RESC();
  { float sacc=pB0[0]+pB0[1]; _Pragma("unroll") for(int r=2;r<16;++r)sacc+=pB0[r]; _Pragma("unroll") for(int r=0;r<16;++r)sacc+=pB1[r]; l_reg+=sacc;
    pw0=(u32x4){PKW(pB0,0),PKW(pB0,2),PKW(pB0,4),PKW(pB0,6)};pw1=(u32x4){PKW(pB0,8),PKW(pB0,10),PKW(pB0,12),PKW(pB0,14)};pw2=(u32x4){PKW(pB1,0),PKW(pB1,2),PKW(pB1,4),PKW(pB1,6)};pw3=(u32x4){PKW(pB1,8),PKW(pB1,10),PKW(pB1,12),PKW(pB1,14)};
    SBAR(); pv(o,vb0+sl_cur,PAF(0),PAF(1),PAF(2),PAF(3)); }
  #undef PKW
  #undef PAF
  #undef VFR
  #undef PIN
  #undef MX3
  #undef GAPA
  #undef GAPB
  #undef EX
  #undef VRD
  #undef KRD
  #undef STEP
  #undef ENDW
  {auto rr=__builtin_amdgcn_permlane32_swap(__float_as_uint(l_reg),__float_as_uint(l_reg),false,false);l_reg=__uint_as_float(rr[0])+__uint_as_float(rr[1]);}
  if(hi==0)wsf[32+r32]=l_reg;asm volatile("s_waitcnt lgkmcnt(0)":::"memory");
  float rli[16];
  #pragma unroll
  for(int r=0;r<16;++r)rli[r]=__builtin_amdgcn_rcpf(wsf[32+crow(r,hi)]);
  bf16*Ow=O+(rowbase+q0+wid*QBLK)*QP+h*D;
  { bf16*stg=(bf16*)(shm+LDS_OST)+wid*2048;
    #pragma unroll
    for(int r=0;r<16;++r){const int orow=crow(r,hi);
      #pragma unroll
      for(int d0=0;d0<2;++d0)stg[orow*64+d0*32+r32]=__float2bfloat16(o[d0][r]*rli[r]);}
    asm volatile("s_waitcnt lgkmcnt(0)":::"memory");
    #pragma unroll
    for(int i=0;i<4;++i){const int row=i*8+(lane>>3),ch=lane&7; const u32x4 v=*(const u32x4*)(stg+row*64+ch*8); ATTN_STORE16(Ow+(long)row*QP+ch*8,v);} }
  asm volatile("s_waitcnt lgkmcnt(0)\n\ts_barrier":::"memory");
  #undef DMA_K
  #undef DMA_V
  #undef CMASK
  #undef START
  #undef RESC
  #undef ROT
}
constexpr int ATTN_LDS_BYTES=LDS_BYTES;
#undef SBAR
#undef WAIT_BAR
}
#define LAS __attribute__((address_space(3)))
typedef unsigned short bf16;
typedef unsigned v4u __attribute__((ext_vector_type(4)));
typedef unsigned v2u __attribute__((ext_vector_type(2)));
typedef float v4f __attribute__((ext_vector_type(4)));
typedef float v2f __attribute__((ext_vector_type(2)));
typedef short h8 __attribute__((ext_vector_type(8)));
typedef short s4 __attribute__((ext_vector_type(4)));
#define XB_TMO      128
#define XB_XCNT(j)  (256  + 64 * (j))
#define XB_XSUB(j)  (1280 + 64 * (j))
#define XB_XGEN(j)  (2304 + 64 * (j))
#define XB_TOP      3328
#define XB_TOPGEN   3392
#define XCD_BAR_WORDS 3456
#define XB_SPIN_CAP (1u << 18)

__device__ __forceinline__ unsigned xb_ld(unsigned* p)              { return __hip_atomic_load(p, __ATOMIC_RELAXED, __HIP_MEMORY_SCOPE_AGENT); }
__device__ __forceinline__ unsigned xb_add(unsigned* p, unsigned v) { return __hip_atomic_fetch_add(p, v, __ATOMIC_RELAXED, __HIP_MEMORY_SCOPE_AGENT); }
__device__ __forceinline__ unsigned xb_xcc_id() { return (unsigned)__builtin_amdgcn_s_getreg((3 << 11) | 20) & 0xFu; }
#define XB_SPIN(cond, bar) do { unsigned _sp = 0; while (cond) { __builtin_amdgcn_s_sleep(1); \
    if ((++_sp & 255u) == 0u) { if (xb_ld(&(bar)[XB_TMO])) break; if (_sp > XB_SPIN_CAP) { atomicAdd(&(bar)[XB_TMO], 1u); break; } } } } while (0)

struct XcdBarrier {
    unsigned* bar; unsigned x;
    volatile LAS unsigned* st;
};

__device__ __forceinline__ XcdBarrier xcd_barrier_post(unsigned* bar, volatile LAS unsigned* st) {
    XcdBarrier b; b.bar = bar; b.x = xb_xcc_id(); b.st = st;
    if (threadIdx.x == 0) (void)xb_add(&bar[XB_XCNT(b.x)], 1u);
    return b;
}
__device__ __forceinline__ void xcd_barrier_complete(unsigned* bar, unsigned x, unsigned& nloc, unsigned& nx) {
    const unsigned G = gridDim.x * gridDim.y * gridDim.z;
    unsigned sum, cnt, mine, sp = 0u;
    for (;;) {
        sum = 0u; cnt = 0u; mine = 0u;
#pragma unroll
        for (unsigned j = 0; j < 16; ++j) { const unsigned c = xb_ld(&bar[XB_XCNT(j)]); sum += c; cnt += (c > 0u) ? 1u : 0u; mine = (j == x) ? c : mine; }
        if (sum == G) break;
        __builtin_amdgcn_s_sleep(1);
        if ((++sp & 255u) == 0u) { if (xb_ld(&bar[XB_TMO])) break; if (sp > XB_SPIN_CAP) { atomicAdd(&bar[XB_TMO], 1u); break; } }
    }
    nloc = mine > 0u ? mine : 1u; nx = cnt > 0u ? cnt : 1u;
}

__device__ __forceinline__ void xcd_barrier(const XcdBarrier& b) {
    asm volatile("s_waitcnt vmcnt(0)" ::: "memory");
    __syncthreads();
    if (threadIdx.x == 0) {
        unsigned* bar = b.bar;
        __builtin_amdgcn_s_waitcnt(0);
        unsigned nloc = b.st[0], nx = b.st[1];
        if (nloc == 0u) { xcd_barrier_complete(bar, b.x, nloc, nx); b.st[0] = nloc; b.st[1] = nx; }
        const unsigned old = xb_add(&bar[XB_XSUB(b.x)], 1u);
        const unsigned gen = old / nloc;
        if (old + 1u == (gen + 1u) * nloc) {
            __builtin_amdgcn_fence(__ATOMIC_RELEASE, "agent");
            asm volatile("s_waitcnt vmcnt(0)" ::: "memory");
            const unsigned og = xb_add(&bar[XB_TOP], 1u);
            const unsigned tg = og / nx;
            if (og + 1u == (tg + 1u) * nx) xb_add(&bar[XB_TOPGEN], 1u);
            else XB_SPIN(xb_ld(&bar[XB_TOPGEN]) == tg, bar);
            __builtin_amdgcn_fence(__ATOMIC_ACQUIRE, "agent");
            xb_add(&bar[XB_XGEN(b.x)], 1u);
            asm volatile("s_waitcnt vmcnt(0)" ::: "memory");
        } else {
            XB_SPIN(xb_ld(&bar[XB_XGEN(b.x)]) == gen, bar);
            __builtin_amdgcn_fence(__ATOMIC_ACQUIRE, "agent");
            asm volatile("s_waitcnt vmcnt(0)" ::: "memory");
        }
    }
    __syncthreads();
}


constexpr int NTHR = 512, NWAVES = 8;
constexpr int DMOD = 1024, MB = 16384, NBATCH = 3, NPROJ = 5888, DFF = 2816;
constexpr int LDS_BYTES = 147456 + 256, LDS_BARW = 147456;
constexpr size_t WS_BAR = 65536;
constexpr size_t MiB = 1u << 20;
constexpr size_t WS_TAB64 = 1 * MiB, WS_TAB128 = 1 * MiB + 65536;
constexpr size_t WS_WIN = 2 * MiB, WS_WBA = 14 * MiB, WS_WBR = 15 * MiB, WS_WOUT = 17 * MiB, WS_WFI = 19 * MiB, WS_WFO = 30 * MiB;
constexpr size_t WS_SS1 = 36 * MiB, WS_SS2 = 37 * MiB;
constexpr size_t WS_XN = 40 * MiB;
constexpr size_t WS_PROJ = 136 * MiB;
constexpr size_t WS_QA = 320 * MiB, WS_KA = 336 * MiB, WS_VA = 340 * MiB, WS_QR = 344 * MiB, WS_KR = 360 * MiB, WS_RET = 376 * MiB;
constexpr size_t WS_ST = 408 * MiB;
constexpr size_t WS_MIX = 408 * MiB, WS_X1B = 440 * MiB, WS_END = 472 * MiB;

__device__ __forceinline__ unsigned f2bf(float f) { unsigned u = __builtin_bit_cast(unsigned, f); return (u + 0x7fffu + ((u >> 16) & 1u)) >> 16; }
__device__ __forceinline__ unsigned pk2(float lo, float hi) { return f2bf(lo) | (f2bf(hi) << 16); }
__device__ __forceinline__ float blo(unsigned u) { return __uint_as_float(u << 16); }
__device__ __forceinline__ float bhi(unsigned u) { return __uint_as_float(u & 0xffff0000u); }
__device__ __forceinline__ float bfs(short s) { return __uint_as_float(((unsigned)(unsigned short)s) << 16); }
__device__ __forceinline__ float wave_sum(float v) {
#pragma unroll
    for (int o = 1; o < 64; o <<= 1) v += __shfl_xor(v, o);
    return v;
}
__device__ __forceinline__ s4 tr_read(LAS const unsigned char* p) { return __builtin_bit_cast(s4, __builtin_amdgcn_ds_read_tr16_b64_v4i16((LAS s4*)p)); }
__device__ __forceinline__ float log2_gamma(float z) { return -log1pf(expf(-z)) * 1.4426950408889634f; }

__device__ __forceinline__ void transpose_item(const float* W, int K, int N, bf16* WT, LAS float* scr, int item, int lane, const float* kscale, int mode) {
    const int nblk = N / 32, kb = item / nblk, nb = item % nblk, k0 = 64 * kb, n0 = 32 * nb;
    int d0 = n0;
    if (mode == 1) { const int bj = n0 / DFF, rem = n0 - bj * DFF; d0 = 256 * (rem / 128) + 128 * bj + (rem % 128); }
#pragma unroll 8
    for (int i = 0; i < 32; ++i) { const int kk = 2 * i + (lane >> 5); float v = W[(size_t)(k0 + kk) * N + n0 + (lane & 31)]; if (kscale) v *= kscale[k0 + kk]; scr[kk * 33 + (lane & 31)] = v; }
    asm volatile("s_waitcnt lgkmcnt(0)" ::: "memory");
    const int c = lane & 7;
#pragma unroll
    for (int j = 0; j < 4; ++j) { const int n = (lane >> 3) + 8 * j; const LAS float* s = scr + (8 * c) * 33 + n;
        v4u o; o.x = pk2(s[0 * 33], s[1 * 33]); o.y = pk2(s[2 * 33], s[3 * 33]); o.z = pk2(s[4 * 33], s[5 * 33]); o.w = pk2(s[6 * 33], s[7 * 33]);
        *(v4u*)(WT + (size_t)(d0 + n) * K + k0 + 8 * c) = o; }
    asm volatile("s_waitcnt lgkmcnt(0)" ::: "memory");
}
__device__ __forceinline__ void rms_row_bf16(const float* xrow, const float* gain, bf16* orow, int lane) {
    const v4f* xr = (const v4f*)xrow + lane; const v4f* gr = (const v4f*)gain + lane;
    v4f v[4]; float s = 0.f;
#pragma unroll
    for (int j = 0; j < 4; ++j) { v[j] = xr[64 * j]; s += (v[j].x * v[j].x + v[j].y * v[j].y) + (v[j].z * v[j].z + v[j].w * v[j].w); }
    const float rstd = rsqrtf(wave_sum(s) * (1.f / DMOD) + 1e-6f);
    v2u* o8 = (v2u*)orow + lane;
#pragma unroll
    for (int j = 0; j < 4; ++j) { const v4f g = gr[64 * j]; v2u o; o.x = pk2(v[j].x * rstd * g.x, v[j].y * rstd * g.y); o.y = pk2(v[j].z * rstd * g.z, v[j].w * rstd * g.w); o8[64 * j] = o; }
}
__device__ __forceinline__ void final_norm_rows(float* out, const float* ss, const float* gain, int gw, int NGW, int lane) {
    for (int m = gw; m < MB; m += NGW) {
        float p = (lane < 16) ? ss[(size_t)m * 16 + lane] : 0.f;
        const float rstd = rsqrtf(wave_sum(p) * (1.f / DMOD) + 1e-6f);
        v4f* xr = (v4f*)(out + (size_t)m * DMOD) + lane; const v4f* gr = (const v4f*)gain + lane;
#pragma unroll
        for (int j = 0; j < 4; ++j) { v4f v = xr[64 * j]; const v4f g = gr[64 * j]; v.x *= rstd * g.x; v.y *= rstd * g.y; v.z *= rstd * g.z; v.w *= rstd * g.w; xr[64 * j] = v; }
    }
}

__device__ __forceinline__ void rope8(float (&v)[8], const v2f* tb, float scale, v4u& o) {
    float r[8];
#pragma unroll
    for (int p = 0; p < 4; ++p) { const v2f cs = tb[p]; const float x0 = v[2 * p], x1 = v[2 * p + 1]; r[2 * p] = (x0 * cs.x - x1 * cs.y) * scale; r[2 * p + 1] = (x0 * cs.y + x1 * cs.x) * scale; }
    o.x = pk2(r[0], r[1]); o.y = pk2(r[2], r[3]); o.z = pk2(r[4], r[5]); o.w = pk2(r[6], r[7]);
}
__device__ __forceinline__ void unpack8(const v4u raw, float (&v)[8]) { v[0] = blo(raw.x); v[1] = bhi(raw.x); v[2] = blo(raw.y); v[3] = bhi(raw.y); v[4] = blo(raw.z); v[5] = bhi(raw.z); v[6] = blo(raw.w); v[7] = bhi(raw.w); }
__device__ __forceinline__ void prep_rows(int T, const bf16* PROJ, bf16* QA, bf16* KA, bf16* VA, bf16* QR, bf16* KR, const float* qn, const float* kn,
                                          const v2f* tab64, const v2f* tab128, int gw, int NGW, int lane) {
    const float C2 = 0.125f * 1.4426950408889634f;
    for (int m = gw; m < MB; m += NGW) {
        const int t = m & (T - 1); const int prow = t >> 6, pcol = t & 63;
        const bf16* pr = PROJ + (size_t)m * NPROJ;
        const int l8 = lane & 7, l16 = lane & 15;
        const v2f* tb64 = tab64 + ((l8 < 4) ? prow : pcol) * 16 + ((4 * l8) & 15);
        const v2f* tb128 = tab128 + ((l16 < 8) ? prow : pcol) * 32 + ((4 * l16) & 31);
        {
            float v[8]; unpack8(*(const v4u*)(pr + 8 * lane), v); float ss = 0.f;
#pragma unroll
            for (int e = 0; e < 8; ++e) ss += v[e] * v[e];
            ss += __shfl_xor(ss, 1); ss += __shfl_xor(ss, 2); ss += __shfl_xor(ss, 4);
            const float rstd = rsqrtf(ss * (1.f / 64.f) + 1e-6f);
#pragma unroll
            for (int e = 0; e < 8; ++e) v[e] *= rstd * qn[8 * l8 + e];
            v4u o; rope8(v, tb64, C2, o); *(v4u*)(QA + (size_t)m * 512 + 8 * lane) = o;
        }
        {
            const int ll = lane & 31; const v4u raw = *(const v4u*)(pr + 512 + 8 * ll);
            float v[8]; unpack8(raw, v); float ss = 0.f;
#pragma unroll
            for (int e = 0; e < 8; ++e) ss += v[e] * v[e];
            ss += __shfl_xor(ss, 1); ss += __shfl_xor(ss, 2); ss += __shfl_xor(ss, 4);
            const float rstd = rsqrtf(ss * (1.f / 64.f) + 1e-6f);
#pragma unroll
            for (int e = 0; e < 8; ++e) v[e] *= rstd * kn[8 * l8 + e];
            v4u o; rope8(v, tb64, 1.0f, o);
            if (lane < 16) *(v4u*)(KA + (size_t)m * 128 + 8 * lane) = o;
            else if (lane < 32) *(v4u*)(VA + (size_t)m * 128 + 8 * (lane - 16)) = raw;
        }
        {
            float v[8]; unpack8(*(const v4u*)(pr + 768 + 8 * lane), v);
            v4u o; rope8(v, tb128, 0.08838834764831845f, o); *(v4u*)(QR + (size_t)m * 512 + 8 * lane) = o;
        }
        {
            float v[8]; unpack8(*(const v4u*)(pr + 1280 + 8 * lane), v);
            v4u o; rope8(v, tb128, 1.0f, o); *(v4u*)(KR + (size_t)m * 512 + 8 * lane) = o;
        }
    }
}

__device__ __forceinline__ void ret_kv_unit(LAS unsigned char* L, const bf16* KR, const bf16* PROJ, bf16* ST, int cgi, int h, float lgf2, float lgb2) {
    const int tid = ltid(), lane = tid & 63, w = tid >> 6, g = lane >> 4, c = lane & 15, q = c >> 2, p = lane & 3;
    const int row0 = cgi * 128;
    constexpr int PK = 288, PV = 544, VOFF = 128 * PK;
#pragma unroll
    for (int i = 0; i < 4; ++i) { const int id = tid + 512 * i, r = id >> 4, cc = id & 15; const v4u v = *(const v4u*)(KR + (size_t)(row0 + r) * 512 + h * 128 + cc * 8); *(LAS v4u*)(L + r * PK + cc * 16) = v; }
#pragma unroll
    for (int i = 0; i < 8; ++i) { const int id = tid + 512 * i, r = id >> 5, cc = id & 31; const v4u v = *(const v4u*)(PROJ + (size_t)(row0 + r) * NPROJ + 1792 + h * 256 + cc * 8); *(LAS v4u*)(L + VOFF + r * PV + cc * 16) = v; }
    __syncthreads();
    LAS const unsigned char* kb = L + (4 * g + q) * PK + (4 * p) * 2;
    LAS const unsigned char* vb = L + VOFF + (4 * g + q) * PV + (32 * w + 4 * p) * 2;
    const int u = cgi * 4 + h;
#pragma unroll 1
    for (int dir = 0; dir < 2; ++dir) {
        const float lg2 = dir ? lgb2 : lgf2;
        v4f acc[8][2];
#pragma unroll
        for (int a = 0; a < 8; ++a)
#pragma unroll
            for (int b = 0; b < 2; ++b) acc[a][b] = (v4f){0.f, 0.f, 0.f, 0.f};
#pragma unroll 1
        for (int ks = 0; ks < 4; ++ks) {
            h8 Bf[2];
#pragma unroll
            for (int et = 0; et < 2; ++et) {
                const s4 lo = tr_read(vb + ks * 32 * PV + et * 32), hi = tr_read(vb + ks * 32 * PV + 16 * PV + et * 32);
                float f[8];
#pragma unroll
                for (int r = 0; r < 4; ++r) { const int jl = 32 * ks + 4 * g + r, jh = jl + 16;
                    f[r] = bfs(lo[r]) * __builtin_amdgcn_exp2f(lg2 * (float)(dir ? jl : 127 - jl));
                    f[4 + r] = bfs(hi[r]) * __builtin_amdgcn_exp2f(lg2 * (float)(dir ? jh : 127 - jh)); }
                v4u pk; pk.x = pk2(f[0], f[1]); pk.y = pk2(f[2], f[3]); pk.z = pk2(f[4], f[5]); pk.w = pk2(f[6], f[7]);
                Bf[et] = __builtin_bit_cast(h8, pk);
            }
#pragma unroll
            for (int dt = 0; dt < 8; ++dt) {
                const s4 lo = tr_read(kb + ks * 32 * PK + dt * 32), hi = tr_read(kb + ks * 32 * PK + 16 * PK + dt * 32);
                const h8 Af = (h8){lo[0], lo[1], lo[2], lo[3], hi[0], hi[1], hi[2], hi[3]};
#pragma unroll
                for (int et = 0; et < 2; ++et) acc[dt][et] = __builtin_amdgcn_mfma_f32_16x16x32_bf16(Af, Bf[et], acc[dt][et], 0, 0, 0);
            }
        }
        bf16* so = ST + (size_t)(u * 2 + dir) * 32768;
#pragma unroll
        for (int dt = 0; dt < 8; ++dt)
#pragma unroll
            for (int et = 0; et < 2; ++et) { v2u o; o.x = pk2(acc[dt][et][0], acc[dt][et][1]); o.y = pk2(acc[dt][et][2], acc[dt][et][3]);
                *(v2u*)(so + (size_t)(32 * w + 16 * et + c) * 128 + 16 * dt + 4 * g) = o; }
    }
    __syncthreads();
}

__device__ __forceinline__ void ret_scan(unsigned* ST32, int nseq, int NC, const float* dec_f, const float* dec_b, int gtid, int gthreads) {
    const int total = nseq * 8 * 16384;
    for (int it = gtid; it < total; it += gthreads) {
        const int chain = it >> 14, off = it & 16383, seq = chain >> 3, h = (chain >> 1) & 3, dir = chain & 1;
        const float Gm = __builtin_amdgcn_exp2f(128.f * log2_gamma(dir ? dec_b[h] : dec_f[h]));
        float s0 = 0.f, s1 = 0.f;
        for (int n0 = 0; n0 < NC; n0 += 8) {
            unsigned v[8];
#pragma unroll
            for (int k = 0; k < 8; ++k) { const int n = dir ? NC - 1 - (n0 + k) : n0 + k; v[k] = ST32[((size_t)((seq * NC + n) * 4 + h) * 2 + dir) * 16384 + off]; }
#pragma unroll
            for (int k = 0; k < 8; ++k) { const int n = dir ? NC - 1 - (n0 + k) : n0 + k; const unsigned o = pk2(s0, s1);
                s0 = Gm * s0 + blo(v[k]); s1 = Gm * s1 + bhi(v[k]);
                ST32[((size_t)((seq * NC + n) * 4 + h) * 2 + dir) * 16384 + off] = o; }
        }
    }
}

__device__ __forceinline__ void ret_out_unit(LAS unsigned char* L, const bf16* QR, const bf16* KR, const bf16* PROJ, const bf16* ST, bf16* RET, const float* rnorm,
                                             int cgi, int h, float lgf2, float lgb2) {
    const int tid = ltid(), lane = tid & 63, w = tid >> 6, g = lane >> 4, c = lane & 15, q = c >> 2, p = lane & 3;
    const int row0 = cgi * 128;
    constexpr int PQ = 272, PV = 544, KOFF = 128 * PQ, VOFF = 2 * 128 * PQ, SOFF = VOFF + 128 * PV;
#pragma unroll
    for (int i = 0; i < 4; ++i) { const int id = tid + 512 * i, r = id >> 4, cc = id & 15;
        const v4u vq = *(const v4u*)(QR + (size_t)(row0 + r) * 512 + h * 128 + cc * 8); const v4u vk = *(const v4u*)(KR + (size_t)(row0 + r) * 512 + h * 128 + cc * 8);
        *(LAS v4u*)(L + r * PQ + cc * 16) = vq; *(LAS v4u*)(L + KOFF + r * PQ + cc * 16) = vk; }
#pragma unroll
    for (int i = 0; i < 8; ++i) { const int id = tid + 512 * i, r = id >> 5, cc = id & 31; const v4u v = *(const v4u*)(PROJ + (size_t)(row0 + r) * NPROJ + 1792 + h * 256 + cc * 8); *(LAS v4u*)(L + VOFF + r * PV + cc * 16) = v; }
    __syncthreads();
    {
        h8 Qf[4];
#pragma unroll
        for (int ks = 0; ks < 4; ++ks) Qf[ks] = *(LAS const h8*)(L + (16 * w + c) * PQ + (32 * ks + 8 * g) * 2);
        v4f sT[8];
#pragma unroll
        for (int jt = 0; jt < 8; ++jt) { v4f a = (v4f){0.f, 0.f, 0.f, 0.f};
#pragma unroll
            for (int ks = 0; ks < 4; ++ks) { const h8 Kf = *(LAS const h8*)(L + KOFF + (16 * jt + c) * PQ + (32 * ks + 8 * g) * 2); a = __builtin_amdgcn_mfma_f32_16x16x32_bf16(Kf, Qf[ks], a, 0, 0, 0); }
            const int i = 16 * w + c;
#pragma unroll
            for (int r = 0; r < 4; ++r) { const int j = 16 * jt + 4 * g + r, df = i - j; const float dec = __builtin_amdgcn_exp2f(df >= 0 ? lgf2 * (float)df : lgb2 * (float)(-df)); a[r] *= dec; }
            sT[jt] = a; }
        __syncthreads();
#pragma unroll
        for (int jt = 0; jt < 8; ++jt) { const int pos = 32 * (jt >> 1) + 8 * g + 4 * (jt & 1); v2u o; o.x = pk2(sT[jt][0], sT[jt][1]); o.y = pk2(sT[jt][2], sT[jt][3]);
            *(LAS v2u*)(L + KOFF + (16 * w + c) * PQ + pos * 2) = o; }
        __syncthreads();
    }
    v4f acc[2][8];
#pragma unroll
    for (int a = 0; a < 2; ++a)
#pragma unroll
        for (int b = 0; b < 8; ++b) acc[a][b] = (v4f){0.f, 0.f, 0.f, 0.f};
    const int u = cgi * 4 + h;
#pragma unroll 1
    for (int dir = 0; dir < 2; ++dir) {
        const bf16* S = ST + (size_t)(u * 2 + dir) * 32768 + (size_t)(32 * w + c) * 128 + 8 * g;
#pragma unroll 1
        for (int ks = 0; ks < 4; ++ks) {
            h8 Sf[2];
#pragma unroll
            for (int et = 0; et < 2; ++et) Sf[et] = *(const h8*)(S + et * 2048 + 32 * ks);
#pragma unroll
            for (int it = 0; it < 8; ++it) { const h8 Qf = *(LAS const h8*)(L + (16 * it + c) * PQ + (32 * ks + 8 * g) * 2);
#pragma unroll
                for (int et = 0; et < 2; ++et) acc[et][it] = __builtin_amdgcn_mfma_f32_16x16x32_bf16(Sf[et], Qf, acc[et][it], 0, 0, 0); }
        }
#pragma unroll
        for (int it = 0; it < 8; ++it) { const int i = 16 * it + c;
            const float sc = dir == 0 ? __builtin_amdgcn_exp2f(lgf2 * (float)(i + 1) - lgb2 * (float)(128 - i)) : __builtin_amdgcn_exp2f(lgb2 * (float)(128 - i));
#pragma unroll
            for (int et = 0; et < 2; ++et) acc[et][it] *= sc; }
    }
    {
        LAS const unsigned char* vb = L + VOFF + (4 * g + q) * PV + (32 * w + 4 * p) * 2;
#pragma unroll 1
        for (int ks = 0; ks < 4; ++ks) {
            h8 Vf[2];
#pragma unroll
            for (int et = 0; et < 2; ++et) { const s4 lo = tr_read(vb + ks * 32 * PV + et * 32), hi = tr_read(vb + ks * 32 * PV + 16 * PV + et * 32);
                Vf[et] = (h8){lo[0], lo[1], lo[2], lo[3], hi[0], hi[1], hi[2], hi[3]}; }
#pragma unroll
            for (int it = 0; it < 8; ++it) { const h8 Pf = *(LAS const h8*)(L + KOFF + (16 * it + c) * PQ + (32 * ks + 8 * g) * 2);
#pragma unroll
                for (int et = 0; et < 2; ++et) acc[et][it] = __builtin_amdgcn_mfma_f32_16x16x32_bf16(Vf[et], Pf, acc[et][it], 0, 0, 0); }
        }
    }
    LAS v2f* stats = (LAS v2f*)(L + SOFF);
#pragma unroll
    for (int it = 0; it < 8; ++it) { float s1 = 0.f, s2 = 0.f;
#pragma unroll
        for (int et = 0; et < 2; ++et)
#pragma unroll
            for (int r = 0; r < 4; ++r) { const float v = acc[et][it][r]; s1 += v; s2 += v * v; }
        s1 += __shfl_xor(s1, 16); s1 += __shfl_xor(s1, 32); s2 += __shfl_xor(s2, 16); s2 += __shfl_xor(s2, 32);
        if (g == 0) stats[(16 * it + c) * 8 + w] = (v2f){s1, s2}; __builtin_amdgcn_sched_barrier(0); }
    __syncthreads();
#pragma unroll
    for (int it = 0; it < 8; ++it) { const int i = 16 * it + c; float s1 = 0.f, s2 = 0.f;
#pragma unroll
        for (int k = 0; k < 8; ++k) { const v2f t = stats[i * 8 + k]; s1 += t.x; s2 += t.y; }
        const float mean = s1 * (1.f / 256.f), var = fmaxf(s2 * (1.f / 256.f) - mean * mean, 0.f), rstd = rsqrtf(var + 1e-6f);
#pragma unroll
        for (int et = 0; et < 2; ++et) { const int e = 32 * w + 16 * et + 4 * g;
            const v4f gn = *(const v4f*)(rnorm + h * 256 + e);
            const v2u gt = *(const v2u*)(PROJ + (size_t)(row0 + i) * NPROJ + 2816 + h * 256 + e);
            const v4f a = acc[et][it];
            v2u o; o.x = pk2((a[0] - mean) * rstd * gn[0] * blo(gt.x), (a[1] - mean) * rstd * gn[1] * bhi(gt.x));
            o.y = pk2((a[2] - mean) * rstd * gn[2] * blo(gt.y), (a[3] - mean) * rstd * gn[3] * bhi(gt.y));
            *(v2u*)(RET + (size_t)(row0 + i) * 1024 + h * 256 + e) = o; }
        asm volatile("" ::: "memory"); __builtin_amdgcn_sched_barrier(0); }
    __syncthreads();
}

struct Args { const float* in[17]; float* out; unsigned char* ws; };
typedef __attribute__((address_space(4))) const Args CArgs;
__device__ __forceinline__ CArgs* kargs() { CArgs* p = (CArgs*)__builtin_amdgcn_kernarg_segment_ptr(); asm volatile("" : "+s"(p)); return p; }
#define WSP(T, off) ((T*)(ws + (off)))
__global__ void __launch_bounds__(NTHR, 2) fwd_mega(Args a_unused) {
    extern __shared__ __attribute__((aligned(16))) unsigned char lds[];
    cg::grid_group grid = cg::this_grid();
    LAS unsigned char* L = (LAS unsigned char*)lds;
    if (threadIdx.x < 2) ((volatile LAS unsigned*)(L + LDS_BARW))[threadIdx.x] = 0u;
#define GRID_BAR() do { CArgs* ap_ = kargs(); XcdBarrier b_; b_.bar = (unsigned*)(ap_->ws + WS_BAR); b_.x = xb_xcc_id(); b_.st = (volatile LAS unsigned*)(L + LDS_BARW); xcd_barrier(b_); } while (0)
#define TIDS const int tid = ltid(), lane = tid & 63, wave = __builtin_amdgcn_readfirstlane(tid >> 6); const int G = lsgpr((int)gridDim.x), bx = lsgpr((int)blockIdx.x); \
    const int vcu = (G % 8 == 0) ? (bx % 8) * (G / 8) + bx / 8 : bx; const int gw = vcu * NWAVES + wave, NGW = G * NWAVES; (void)lane; (void)gw; (void)NGW; (void)vcu

    {
        CArgs* ap = kargs(); unsigned char* ws = ap->ws; TIDS;
        LAS float* scr = (LAS float*)(L + wave * 16384);
        constexpr int I_IN = (1024 / 64) * (NPROJ / 32), I_BA = (512 / 64) * (1024 / 32), I_BR = (1024 / 64) * (1024 / 32), I_OUT = I_BR, I_FI = (1024 / 64) * (2 * DFF / 32), I_FO = (DFF / 64) * (1024 / 32);
        constexpr int NITEMS = I_IN + I_BA + I_BR + I_OUT + I_FI + I_FO;
        for (int it = gw; it < NITEMS; it += NGW) {
            int r = it;
            if (r < I_IN) { transpose_item(ap->in[3], 1024, NPROJ, WSP(bf16, WS_WIN), scr, r, lane, nullptr, 0); continue; } r -= I_IN;
            if (r < I_BA) { transpose_item(ap->in[10], 512, 1024, WSP(bf16, WS_WBA), scr, r, lane, nullptr, 0); continue; } r -= I_BA;
            if (r < I_BR) { transpose_item(ap->in[11], 1024, 1024, WSP(bf16, WS_WBR), scr, r, lane, nullptr, 0); continue; } r -= I_BR;
            if (r < I_OUT) { transpose_item(ap->in[12], 1024, 1024, WSP(bf16, WS_WOUT), scr, r, lane, nullptr, 0); continue; } r -= I_OUT;
            if (r < I_FI) { transpose_item(ap->in[14], 1024, 2 * DFF, WSP(bf16, WS_WFI), scr, r, lane, ap->in[13], 1); continue; } r -= I_FI;
            transpose_item(ap->in[15], DFF, 1024, WSP(bf16, WS_WFO), scr, r, lane, nullptr, 0);
        }
        const float* x_prompt = ap->in[0]; const float* x_sample = ap->in[1]; const float* nmix = ap->in[2]; bf16* XN = WSP(bf16, WS_XN);
        for (int m = gw; m < NBATCH * MB; m += NGW) {
            const float* xr = (m < 2 * MB) ? x_prompt + (size_t)m * DMOD : x_sample + (size_t)(m - 2 * MB) * DMOD;
            rms_row_bf16(xr, nmix, XN + (size_t)m * DMOD, lane);
        }
        if (bx == 0) { for (int i = tid; i < XCD_BAR_WORDS; i += NTHR) WSP(unsigned, WS_BAR)[i] = 0u; }
        const int gt = bx * NTHR + tid;
        if (gt < 4096 + 8192) {
            const bool big = gt >= 4096; const int idx = big ? gt - 4096 : gt; const int nf = big ? 32 : 16; const int pos = idx / nf, f = idx % nf;
            const float inv = exp2f(-(float)f / (float)nf * 13.287712379549449f);
            float rev = (float)pos * inv * 0.15915494309189535f; rev -= floorf(rev);
            const v2f cs = (v2f){__builtin_amdgcn_cosf(rev), __builtin_amdgcn_sinf(rev)};
            if (big) WSP(v2f, WS_TAB128)[idx] = cs; else WSP(v2f, WS_TAB64)[idx] = cs;
        }
    }
    grid.sync();
    { CArgs* ap_ = kargs(); (void)xcd_barrier_post((unsigned*)(ap_->ws + WS_BAR), (volatile LAS unsigned*)(L + LDS_BARW)); }

#pragma unroll 1
    for (int b = 0; b < NBATCH; ++b) {
        if (b > 0) { CArgs* ap = kargs(); unsigned char* ws = ap->ws; TIDS; final_norm_rows(ap->out + (size_t)(b - 1) * MB * DMOD, WSP(float, WS_SS2), ap->in[16], gw, NGW, lane); }
        __syncthreads();
#ifndef SKIP_P1
        {
            CArgs* ap = kargs(); unsigned char* ws = ap->ws; TIDS;
            pg8::Gemm g{WSP(bf16, WS_XN) + (size_t)b * MB * DMOD, WSP(bf16, WS_WIN), MB, NPROJ, DMOD}; pg8::StaticOrder S; S.init(MB, NPROJ, G, bx);
            pg8::EpiProj E{WSP(bf16, WS_PROJ), ap->in[4]};
            pg8::gemm_phase<pg8::EpiProj, pg8::StaticOrder, true, true>(L, g, S, E);
#ifdef PROBE_G1
            pg8::gemm_phase<pg8::EpiProj, pg8::StaticOrder, true, true>(L, g, S, E);
#endif
        }
#endif
        GRID_BAR();
#ifdef PROBE_SYNC
        GRID_BAR();
#endif
#ifndef SKIP_P1B
        { CArgs* ap = kargs(); unsigned char* ws = ap->ws; TIDS;
          prep_rows((b < 2) ? 2048 : 16384, WSP(bf16, WS_PROJ), WSP(bf16, WS_QA), WSP(bf16, WS_KA), WSP(bf16, WS_VA), WSP(bf16, WS_QR), WSP(bf16, WS_KR), ap->in[5], ap->in[6],
                    WSP(v2f, WS_TAB64), WSP(v2f, WS_TAB128), gw, NGW, lane);
#ifdef PROBE_P1B
          prep_rows((b < 2) ? 2048 : 16384, WSP(bf16, WS_PROJ), WSP(bf16, WS_QA), WSP(bf16, WS_KA), WSP(bf16, WS_VA), WSP(bf16, WS_QR), WSP(bf16, WS_KR), ap->in[5], ap->in[6],
                    WSP(v2f, WS_TAB64), WSP(v2f, WS_TAB128), gw, NGW, lane);
#endif
          }
#endif
        GRID_BAR();
#ifdef PROBE_SYNC
        GRID_BAR();
#endif
#ifndef SKIP_P2
        {
            { CArgs* ap = kargs(); unsigned char* ws = ap->ws; TIDS; const int per = (512 + G - 1) / G;
#ifdef PROBE_ATT
              for (int i = 0; i < per; ++i) { const int u = vcu * per + i; if (u >= 512) break;
                long rowbase; int hh, qb;
                if (b < 2) { rowbase = (long)(u >> 6) * 2048; hh = (u >> 3) & 7; qb = u & 7; } else { rowbase = 0; hh = u >> 6; qb = u & 63; }
                attn_body::attn_unit<8>(rowbase, (b < 2) ? 2048 : 16384, hh, qb, WSP(const attn_body::bf16, WS_QA), WSP(const attn_body::bf16, WS_KA), WSP(const attn_body::bf16, WS_VA), WSP(attn_body::bf16, WS_RET), (char*)lds);
              }
#endif
#ifndef SKIP_ATT
              for (int i = 0; i < per; ++i) { const int u = vcu * per + i; if (u >= 512) break;
                long rowbase; int hh, qb;
                if (b < 2) { rowbase = (long)(u >> 6) * 2048; hh = (u >> 3) & 7; qb = u & 7; } else { rowbase = 0; hh = u >> 6; qb = u & 63; }
                attn_body::attn_unit<8>(rowbase, (b < 2) ? 2048 : 16384, hh, qb, WSP(const attn_body::bf16, WS_QA), WSP(const attn_body::bf16, WS_KA), WSP(const attn_body::bf16, WS_VA), WSP(attn_body::bf16, WS_QA), (char*)lds);
              }
#endif
            }
            __syncthreads();
            { CArgs* ap = kargs(); unsigned char* ws = ap->ws; TIDS; const int per = (512 + G - 1) / G;
#ifndef SKIP_KV
              for (int i = 0; i < per; ++i) { const int u = vcu * per + i; if (u >= 512) break;
                const int hh = u & 3;
                ret_kv_unit(L, WSP(bf16, WS_KR), WSP(bf16, WS_PROJ), WSP(bf16, WS_ST), u >> 2, hh, log2_gamma(ap->in[7][hh]), log2_gamma(ap->in[8][hh]));
#ifdef PROBE_RET
                ret_kv_unit(L, WSP(bf16, WS_KR), WSP(bf16, WS_PROJ), WSP(bf16, WS_ST), u >> 2, hh, log2_gamma(ap->in[7][hh]), log2_gamma(ap->in[8][hh]));
#endif
              }
#endif
            }
        }
#endif
        GRID_BAR();
#ifdef PROBE_SYNC
        GRID_BAR();
#endif
#ifndef SKIP_P3
        { CArgs* ap = kargs(); unsigned char* ws = ap->ws; TIDS; const int T = (b < 2) ? 2048 : 16384;
          ret_scan(WSP(unsigned, WS_ST), MB / T, T / 128, ap->in[7], ap->in[8], bx * NTHR + tid, G * NTHR); }
#endif
        GRID_BAR();
#ifdef PROBE_SYNC
        GRID_BAR();
#endif
#ifndef SKIP_P4
        {
            CArgs* ap = kargs(); unsigned char* ws = ap->ws; TIDS;
            const int per = (512 + G - 1) / G;
            for (int i = 0; i < per; ++i) { const int u = vcu * per + i; if (u >= 512) break;
                const int hh = u & 3;
                ret_out_unit(L, WSP(bf16, WS_QR), WSP(bf16, WS_KR), WSP(bf16, WS_PROJ), WSP(bf16, WS_ST), WSP(bf16, WS_RET), ap->in[9], u >> 2, hh, log2_gamma(ap->in[7][hh]), log2_gamma(ap->in[8][hh]));
#ifdef PROBE_RET
                ret_out_unit(L, WSP(bf16, WS_QR), WSP(bf16, WS_KR), WSP(bf16, WS_PROJ), WSP(bf16, WS_ST), WSP(bf16, WS_RET), ap->in[9], u >> 2, hh, log2_gamma(ap->in[7][hh]), log2_gamma(ap->in[8][hh]));
#endif
            }
        }
#endif
        GRID_BAR();
#ifdef PROBE_SYNC
        GRID_BAR();
#endif
#ifndef SKIP_P5
        {
            { CArgs* ap = kargs(); unsigned char* ws = ap->ws; TIDS; pg8::StaticOrder S; S.init(MB, 1024, G, bx);
              pg8::Gemm g{WSP(bf16, WS_QA), WSP(bf16, WS_WBA), MB, 1024, 512}; pg8::EpiBranch<false> E{WSP(bf16, WS_PROJ) + 3840, WSP(bf16, WS_MIX)};
              pg8::gemm_phase<pg8::EpiBranch<false>, pg8::StaticOrder, true, true>(L, g, S, E); }
            asm volatile("s_waitcnt vmcnt(0)" ::: "memory"); __syncthreads();
            { CArgs* ap = kargs(); unsigned char* ws = ap->ws; TIDS; pg8::StaticOrder S; S.init(MB, 1024, G, bx);
              pg8::Gemm g{WSP(bf16, WS_RET), WSP(bf16, WS_WBR), MB, 1024, 1024}; pg8::EpiBranch<true> E{WSP(bf16, WS_PROJ) + 4864, WSP(bf16, WS_MIX)};
              pg8::gemm_phase<pg8::EpiBranch<true>, pg8::StaticOrder, true, true>(L, g, S, E); }
#ifdef PROBE_G5
            asm volatile("s_waitcnt vmcnt(0)" ::: "memory"); __syncthreads();
            { CArgs* ap = kargs(); unsigned char* ws = ap->ws; TIDS; pg8::StaticOrder S; S.init(MB, 1024, G, bx);
              pg8::Gemm g{WSP(bf16, WS_QA), WSP(bf16, WS_WBA), MB, 1024, 512}; pg8::EpiBranch<false> E{WSP(bf16, WS_PROJ) + 3840, WSP(bf16, WS_MIX)};
              pg8::gemm_phase<pg8::EpiBranch<false>, pg8::StaticOrder, true, true>(L, g, S, E); }
            asm volatile("s_waitcnt vmcnt(0)" ::: "memory"); __syncthreads();
            { CArgs* ap = kargs(); unsigned char* ws = ap->ws; TIDS; pg8::StaticOrder S; S.init(MB, 1024, G, bx);
              pg8::Gemm g{WSP(bf16, WS_RET), WSP(bf16, WS_WBR), MB, 1024, 1024}; pg8::EpiBranch<true> E{WSP(bf16, WS_PROJ) + 4864, WSP(bf16, WS_MIX)};
              pg8::gemm_phase<pg8::EpiBranch<true>, pg8::StaticOrder, true, true>(L, g, S, E); }
#endif
        }
#endif
        GRID_BAR();
#ifdef PROBE_SYNC
        GRID_BAR();
#endif
#ifndef SKIP_P6
        {
            CArgs* ap = kargs(); unsigned char* ws = ap->ws; TIDS;
            const float* xb = (b < 2) ? ap->in[0] + (size_t)b * MB * DMOD : ap->in[1];
            pg8::Gemm g{WSP(bf16, WS_MIX), WSP(bf16, WS_WOUT), MB, 1024, 1024}; pg8::StaticOrder S; S.init(MB, 1024, G, bx);
            pg8::EpiResid E{xb, ap->out + (size_t)b * MB * DMOD, WSP(bf16, WS_X1B), WSP(float, WS_SS1)};
            pg8::gemm_phase<pg8::EpiResid, pg8::StaticOrder, true, true>(L, g, S, E);
#ifdef PROBE_G5
            pg8::gemm_phase<pg8::EpiResid, pg8::StaticOrder, true, true>(L, g, S, E);
#endif
        }
#endif
        GRID_BAR();
#ifdef PROBE_SYNC
        GRID_BAR();
#endif
#ifndef SKIP_P7
        {
            CArgs* ap = kargs(); unsigned char* ws = ap->ws; TIDS;
            pg8::Gemm g{WSP(bf16, WS_X1B), WSP(bf16, WS_WFI), MB, 2 * DFF, 1024}; pg8::StaticOrder S; S.init(MB, 2 * DFF, G, bx);
            pg8::EpiFfnIn E{WSP(float, WS_SS1), WSP(bf16, WS_PROJ)};
            pg8::gemm_phase<pg8::EpiFfnIn, pg8::StaticOrder, true, true>(L, g, S, E);
#ifdef PROBE_G7
            pg8::gemm_phase<pg8::EpiFfnIn, pg8::StaticOrder, true, true>(L, g, S, E);
#endif
        }
#endif
        GRID_BAR();
#ifdef PROBE_SYNC
        GRID_BAR();
#endif
#ifndef SKIP_P8
        {
            CArgs* ap = kargs(); unsigned char* ws = ap->ws; TIDS; float* outb = ap->out + (size_t)b * MB * DMOD;
            pg8::Gemm g{WSP(bf16, WS_PROJ), WSP(bf16, WS_WFO), MB, 1024, DFF}; pg8::StaticOrder S; S.init(MB, 1024, G, bx);
            pg8::EpiResid E{outb, outb, nullptr, WSP(float, WS_SS2)};
            pg8::gemm_phase<pg8::EpiResid, pg8::StaticOrder, true, true>(L, g, S, E);
        }
#endif
        GRID_BAR();
#ifdef PROBE_SYNC
        GRID_BAR();
#endif
    }
    { CArgs* ap = kargs(); unsigned char* ws = ap->ws; TIDS; final_norm_rows(ap->out + (size_t)(NBATCH - 1) * MB * DMOD, WSP(float, WS_SS2), ap->in[16], gw, NGW, lane); }
}

extern "C" void kernel_launch(void* const* d_in, const int* in_sizes, int n_in, void* d_out, int out_size, void* d_ws, size_t ws_size, hipStream_t stream) {
    static int grid = 0;
    if (grid == 0) {
        if (n_in != 17 || ws_size < WS_END) { fprintf(stderr, "kernel_launch: unexpected n_in %d / ws_size %zu\n", n_in, ws_size); grid = -1; return; }
        int dev = 0, cus = 0, per_cu = 0;
        hipGetDevice(&dev); hipDeviceGetAttribute(&cus, hipDeviceAttributeMultiprocessorCount, dev);
        if (hipFuncSetAttribute((const void*)fwd_mega, hipFuncAttributeMaxDynamicSharedMemorySize, LDS_BYTES) != hipSuccess) fprintf(stderr, "kernel_launch: hipFuncSetAttribute failed\n");
        if (hipOccupancyMaxActiveBlocksPerMultiprocessor(&per_cu, (const void*)fwd_mega, NTHR, LDS_BYTES) != hipSuccess || per_cu < 1) { fprintf(stderr, "kernel_launch: occupancy query gave %d\n", per_cu); per_cu = 1; }
        (void)hipGetLastError();
        grid = cus * per_cu;
    }
    if (grid < 0) return;
    Args a{};
    for (int i = 0; i < 17; ++i) a.in[i] = (const float*)d_in[i];
    a.out = (float*)d_out; a.ws = (unsigned char*)d_ws;
    void* args[] = {&a};
    hipError_t e = hipLaunchCooperativeKernel((const void*)fwd_mega, dim3(grid), dim3(NTHR), args, LDS_BYTES, stream);
    if (e != hipSuccess) fprintf(stderr, "cooperative launch failed: %s (grid %d)\n", hipGetErrorString(e), grid);
}
```
